# Optimizing an MI355X kernel written in HIP

```python
import jax
import jax.numpy as jnp
from jax import lax
import numpy as np

D_MODEL = 1024
BATCH = 2
SEQ = 8192
DEPTH = 2

RET_HEADS = 4
RET_DK = 128
RET_DV = 256
RET_CHUNK = 128
SWA_Q_HEADS = 16
SWA_KV_HEADS = 2
SWA_HEAD_DIM = 64
WINDOW = 128
SWA_BLOCK = 128
D_FF = 2816
ROPE_THETA = 10000.0
NORM_EPS = 1e-6
MAX_POS_OFFSET = 1024
N_MOD = 9

RET_QK_WIDTH = RET_HEADS * RET_DK
RET_V_WIDTH = RET_HEADS * RET_DV
SWA_Q_WIDTH = SWA_Q_HEADS * SWA_HEAD_DIM
SWA_KV_WIDTH = SWA_KV_HEADS * SWA_HEAD_DIM
IN_SPLITS = (RET_QK_WIDTH, RET_QK_WIDTH, RET_V_WIDTH, RET_V_WIDTH, SWA_Q_WIDTH, SWA_KV_WIDTH, SWA_KV_WIDTH, D_MODEL, D_MODEL)
IN_COLS = sum(IN_SPLITS)

kernel_name = 'hybrid_retention_swa_macaron_adaln'


def rmsnorm(x, gain):
    xf = x.astype(jnp.float32)
    y = xf * lax.rsqrt(jnp.mean(xf * xf, axis=-1, keepdims=True) + NORM_EPS)
    return (y * gain.astype(jnp.float32)).astype(x.dtype)


def modulate(h, shift, scale):
    return h * (1 + scale[:, None, :]) + shift[:, None, :]


def swiglu(h, w_up, w_down):
    gate, up = jnp.split(h @ w_up, 2, axis=-1)
    return (jax.nn.silu(gate) * up) @ w_down


def rope_tables(positions, dim):
    inv_freq = 1.0 / (ROPE_THETA ** (jnp.arange(0, dim, 2, dtype=jnp.float32) / dim))
    ang = positions.astype(jnp.float32)[..., None] * inv_freq
    return jnp.cos(ang), jnp.sin(ang)


def apply_rope(x, cos, sin):
    xf = x.astype(jnp.float32)
    x1, x2 = jnp.split(xf, 2, axis=-1)
    c = cos[:, :, None, :]
    s = sin[:, :, None, :]
    return jnp.concatenate([x1 * c - x2 * s, x2 * c + x1 * s], axis=-1).astype(x.dtype)


def head_groupnorm(y):
    mu = jnp.mean(y, axis=-1, keepdims=True)
    var = jnp.mean(jnp.square(y - mu), axis=-1, keepdims=True)
    return (y - mu) * lax.rsqrt(var + NORM_EPS)


def chunkwise_retention(q, k, v):
    B, T, H, dk = q.shape
    dv = v.shape[-1]
    C = RET_CHUNK
    N = T // C
    f32 = jnp.float32
    log_gamma = jnp.log1p(-(2.0 ** (-5.0 - jnp.arange(H, dtype=f32))))
    qc = (q.astype(f32) * (dk ** -0.5)).reshape(B, N, C, H, dk)
    kc = k.astype(f32).reshape(B, N, C, H, dk)
    vc = v.astype(f32).reshape(B, N, C, H, dv)
    idx = jnp.arange(C, dtype=f32)
    rel = idx[:, None] - idx[None, :]
    decay_intra = jnp.where(rel[None] >= 0,
                            jnp.exp(jnp.maximum(rel, 0.0)[None] * log_gamma[:, None, None]),
                            0.0)
    scores = jnp.einsum('bnihd,bnjhd->bnhij', qc, kc) * decay_intra[None, None]
    intra = jnp.einsum('bnhij,bnjhe->bnihe', scores, vc)
    zeta = jnp.exp((C - 1 - idx)[None, :] * log_gamma[:, None])
    xi = jnp.exp((idx + 1)[None, :] * log_gamma[:, None])
    chunk_kv = jnp.einsum('bnjhd,hj,bnjhe->nbhde', kc, zeta, vc)
    gamma_chunk = jnp.exp(C * log_gamma)[None, :, None, None]

    def step(state, kv_n):
        return state * gamma_chunk + kv_n, state

    _, prev_states = lax.scan(step, jnp.zeros((B, H, dk, dv), f32), chunk_kv)
    cross = jnp.einsum('bnihd,nbhde,hi->bnihe', qc, prev_states, xi)
    return (intra + cross).reshape(B, T, H, dv)


def sliding_window_gqa_sinks(q, k, v, sinks):
    B, T, Hq, d = q.shape
    Hkv = k.shape[2]
    G = Hq // Hkv
    C = SWA_BLOCK
    N = T // C
    qb = q.reshape(B, N, C, Hkv, G, d)
    kb = k.reshape(B, N, C, Hkv, d)
    vb = v.reshape(B, N, C, Hkv, d)
    pad = jnp.zeros_like(kb[:, :1])
    k2 = jnp.concatenate([jnp.concatenate([pad, kb[:, :-1]], axis=1), kb], axis=2)
    v2 = jnp.concatenate([jnp.concatenate([pad, vb[:, :-1]], axis=1), vb], axis=2)
    scores = jnp.einsum('bnikgd,bnjkd->bkgnij', qb, k2).astype(jnp.float32) * (d ** -0.5)
    qi = jnp.arange(C)[:, None] + C
    kj = jnp.arange(2 * C)[None, :]
    rel = qi - kj
    band = (rel >= 0) & (rel < WINDOW)
    blk_valid = (jnp.arange(N)[:, None, None] > 0) | (kj >= C)[None]
    mask = band[None] & blk_valid
    scores = jnp.where(mask, scores, -jnp.inf)
    sink = jnp.broadcast_to(sinks.astype(jnp.float32).reshape(Hkv, G)[None, :, :, None, None, None],
                            scores.shape[:-1] + (1,))
    logits = jnp.concatenate([scores, sink], axis=-1)
    m = jnp.max(logits, axis=-1, keepdims=True)
    p = jnp.exp(logits - m)
    probs = p[..., :-1] / jnp.sum(p, axis=-1, keepdims=True)
    out = jnp.einsum('bkgnij,bnjkd->bnikgd', probs.astype(v.dtype), v2)
    return out.reshape(B, T, Hq * d)


def hybrid_mixer(h, cos_r, sin_r, cos_s, sin_s, w_in, sinks, w_branch_ret, w_branch_swa, w_out):
    B, T, _ = h.shape
    offsets = np.cumsum(IN_SPLITS)[:-1]
    rq, rk, rv, rg, sq, sk, sv, gate_r, gate_s = jnp.split(h @ w_in, offsets, axis=-1)
    rq = apply_rope(rq.reshape(B, T, RET_HEADS, RET_DK), cos_r, sin_r)
    rk = apply_rope(rk.reshape(B, T, RET_HEADS, RET_DK), cos_r, sin_r)
    ret = chunkwise_retention(rq, rk, rv.reshape(B, T, RET_HEADS, RET_DV))
    ret = head_groupnorm(ret).reshape(B, T, RET_V_WIDTH).astype(h.dtype)
    ret = jax.nn.silu(rg) * ret
    branch_ret = ret @ w_branch_ret
    sq = apply_rope(sq.reshape(B, T, SWA_Q_HEADS, SWA_HEAD_DIM), cos_s, sin_s)
    sk = apply_rope(sk.reshape(B, T, SWA_KV_HEADS, SWA_HEAD_DIM), cos_s, sin_s)
    sv = sv.reshape(B, T, SWA_KV_HEADS, SWA_HEAD_DIM)
    branch_swa = sliding_window_gqa_sinks(sq, sk, sv, sinks) @ w_branch_swa
    merged = jax.nn.sigmoid(gate_r) * branch_ret + jax.nn.sigmoid(gate_s) * branch_swa
    return merged @ w_out


def setup_inputs(seed: int = 0) -> dict:
    key = jax.random.key(seed)
    ks = jax.random.split(key, 20)
    f32 = jnp.float32

    def dense(k, shape, fan_in, mult=1.0):
        return jax.random.normal(k, shape, f32) * (mult * fan_in ** -0.5)

    def gains(k, shape):
        return 1.0 + 0.05 * jax.random.normal(k, shape, f32)

    x = jax.random.normal(ks[0], (BATCH, SEQ, D_MODEL), f32)
    c = jax.random.normal(ks[1], (BATCH, D_MODEL), f32)
    offset = jax.random.randint(ks[2], (BATCH, 1), 0, MAX_POS_OFFSET, dtype=jnp.int32)
    positions = (offset + jnp.arange(SEQ, dtype=jnp.int32)[None, :]).astype(jnp.int32)
    return {
        'x': x,
        'c': c,
        'positions': positions,
        'norm_ffn1': gains(ks[3], (DEPTH, D_MODEL)),
        'norm_mix': gains(ks[4], (DEPTH, D_MODEL)),
        'norm_ffn2': gains(ks[5], (DEPTH, D_MODEL)),
        'final_norm': gains(ks[6], (D_MODEL,)),
        'w_ada': dense(ks[7], (DEPTH, D_MODEL, N_MOD * D_MODEL), D_MODEL, 0.5),
        'b_ada': 0.02 * jax.random.normal(ks[8], (DEPTH, N_MOD * D_MODEL), f32),
        'ffn1_w_up': dense(ks[9], (DEPTH, D_MODEL, 2 * D_FF), D_MODEL),
        'ffn1_w_down': dense(ks[10], (DEPTH, D_FF, D_MODEL), D_FF),
        'ffn2_w_up': dense(ks[11], (DEPTH, D_MODEL, 2 * D_FF), D_MODEL),
        'ffn2_w_down': dense(ks[12], (DEPTH, D_FF, D_MODEL), D_FF),
        'w_in': dense(ks[13], (DEPTH, D_MODEL, IN_COLS), D_MODEL),
        'sinks': jax.random.normal(ks[14], (DEPTH, SWA_Q_HEADS), f32),
        'w_branch_ret': dense(ks[15], (DEPTH, RET_V_WIDTH, D_MODEL), RET_V_WIDTH),
        'w_branch_swa': dense(ks[16], (DEPTH, SWA_Q_WIDTH, D_MODEL), SWA_Q_WIDTH),
        'w_out': dense(ks[17], (DEPTH, D_MODEL, D_MODEL), D_MODEL),
    }


def reference(x, c, positions, norm_ffn1, norm_mix, norm_ffn2, final_norm, w_ada, b_ada,
              ffn1_w_up, ffn1_w_down, ffn2_w_up, ffn2_w_down, w_in, sinks,
              w_branch_ret, w_branch_swa, w_out):
    cos_r, sin_r = rope_tables(positions, RET_DK)
    cos_s, sin_s = rope_tables(positions, SWA_HEAD_DIM)
    c_act = jax.nn.silu(c)
    for l in range(DEPTH):
        mod = c_act @ w_ada[l] + b_ada[l]
        sh1, sc1, g1, sh2, sc2, g2, sh3, sc3, g3 = jnp.split(mod, N_MOD, axis=-1)
        h = modulate(rmsnorm(x, norm_ffn1[l]), sh1, sc1)
        x = x + 0.5 * g1[:, None, :] * swiglu(h, ffn1_w_up[l], ffn1_w_down[l])
        h = modulate(rmsnorm(x, norm_mix[l]), sh2, sc2)
        x = x + g2[:, None, :] * hybrid_mixer(h, cos_r, sin_r, cos_s, sin_s, w_in[l], sinks[l],
                                              w_branch_ret[l], w_branch_swa[l], w_out[l])
        h = modulate(rmsnorm(x, norm_ffn2[l]), sh3, sc3)
        x = x + 0.5 * g3[:, None, :] * swiglu(h, ffn2_w_up[l], ffn2_w_down[l])
    return rmsnorm(x, final_norm)
```

```cpp
#include <hip/hip_runtime.h>
#include <cstdio>
#include <cstdint>
namespace pg8 {
#define PG8_LAS __attribute__((address_space(3)))
typedef unsigned short bf16_t;
typedef short bf16x8 __attribute__((ext_vector_type(8)));
typedef float f32x4 __attribute__((ext_vector_type(4)));
typedef unsigned u32x4 __attribute__((ext_vector_type(4)));
constexpr int BM = 256, BK = 64, HALF = 128, HTB = HALF * BK * 2  , STAGE_BYTES = 8 * HTB, NXCD = 8, WGM = 8;

__host__ __device__ __forceinline__ int lds_byte(int r, int c) { const int st = (r >> 4) * 2 + (c >> 5), rr = r & 15, cc = c & 31, ob = rr * 64 + cc * 2; return st * 1024 + (ob ^ (((ob >> 9) & 1) << 5)); }
__host__ __device__ __forceinline__ void stage_rc(int b, int& R, int& C) { const int st = b / 1024, sb = b % 1024, swz = sb ^ (((sb >> 9) & 1) << 5); R = (st >> 1) * 16 + swz / 64; C = (st & 1) * 32 + (swz % 64) / 2; }
__host__ __device__ __forceinline__ int perm32(int rho) { const int n = rho >> 4, i = rho & 15; return 8 * (i >> 2) + 4 * n + (i & 3); }

struct Unit { int pm, pn; };
struct Gemm { const bf16_t* A; const bf16_t* Bt; int M, N, K; };

struct StaticOrder {
    int nM, nN, nwg, G, c;
    __host__ __device__ void init(int M, int N, int G_, int c_) { nM = M / BM; nN = N / BM; nwg = nM * nN; G = G_; c = c_; }
    __host__ __device__ bool next(int i, Unit& u) const {
        const long L = (long)i * G + c; if (L >= nwg) return false;
        int wgid = (int)L; { const int q = nwg / NXCD, r = nwg % NXCD, xcd = wgid % NXCD, off = wgid / NXCD; wgid = (xcd < r ? xcd * (q + 1) : r * (q + 1) + (xcd - r) * q) + off; }
        const int nig = WGM * nN, gid = wgid / nig, fm = gid * WGM, gsz = (nM - fm) < WGM ? (nM - fm) : WGM;
        u.pm = fm + ((wgid % nig) % gsz); u.pn = (wgid % nig) / gsz; return true;
    }
    __device__ __forceinline__ void a_ready(const Unit&) const {}
    __device__ __forceinline__ void done(const Unit&) const {}
};

template <class Epi, class Sched, bool ALIGN_EPI = false, bool SP2 = false>
__device__ __forceinline__ void gemm_phase(PG8_LAS unsigned char* lds, const Gemm g, const Sched& S, const Epi& E) {
    int tid_ = threadIdx.x; asm volatile("" : "+v"(tid_));
    const int tid = tid_, wid = __builtin_amdgcn_readfirstlane(tid >> 6), lane = tid & 63, wr = wid >> 2, wc = wid & 3, fr = lane & 15, fq = lane >> 4;
    const int K = g.K, nt = K / BK;
    unsigned voffA[2], voffB[2];
#pragma unroll
    for (int i = 0; i < 2; ++i) { int R, C; stage_rc(tid * 16 + i * 8192, R, C); const int Rb = Epi::PERM ? ((R & ~31) + perm32(R & 31)) : R;
        voffA[i] = (unsigned)(R * K + C) * 2u; voffB[i] = (unsigned)(Rb * K + C) * 2u; }
    const size_t kstep = (size_t)(BK * 2);
    const size_t hstep = (size_t)HALF * K * 2;
    const size_t tstep = 2 * hstep;
    const unsigned ldsw = (unsigned)wid * 1024u;
    const int aoff = lds_byte(wr * 64 + fr, fq * 8), boff = lds_byte(wc * 32 + fr, fq * 8);
#define PG8_SA(b, h) (((b) * 2 + (h)) * HTB)
#define PG8_SB(b, h) ((4 + (b) * 2 + (h)) * HTB)
#define PG8_STAGE(bufoff, gbase, voff) do { _Pragma("unroll") for (int _i = 0; _i < 2; ++_i) \
        __builtin_amdgcn_global_load_lds((const unsigned*)((const char*)(gbase) + (voff)[_i]), (PG8_LAS unsigned*)(lds + (bufoff) + ldsw + _i * 8192), 16, 0, 0); } while (0)
#define PG8_LDA(dst, b, h) do { _Pragma("unroll") for (int m = 0; m < 4; ++m) _Pragma("unroll") for (int k = 0; k < 2; ++k) dst[m][k] = *(const PG8_LAS bf16x8*)(lds + PG8_SA(b, h) + aoff + m * 2048 + k * 1024); } while (0)
#define PG8_LDB(dst, b, h) do { _Pragma("unroll") for (int n = 0; n < 2; ++n) _Pragma("unroll") for (int k = 0; k < 2; ++k) dst[n][k] = *(const PG8_LAS bf16x8*)(lds + PG8_SB(b, h) + boff + n * 2048 + k * 1024); } while (0)
#define PG8_MMA(ai, bj, At, Bt) do { __builtin_amdgcn_s_setprio(1); _Pragma("unroll") for (int m = 0; m < 4; ++m) _Pragma("unroll") for (int n = 0; n < 2; ++n) _Pragma("unroll") for (int k = 0; k < 2; ++k) \
        acc[ai][bj][m][n] = __builtin_amdgcn_mfma_f32_16x16x32_bf16(Bt[n][k], At[m][k], acc[ai][bj][m][n], 0, 0, 0); __builtin_amdgcn_s_setprio(0); } while (0)
#define PG8_WAIT_V(n) asm volatile("s_waitcnt vmcnt(" #n ")" ::: "memory")
#define PG8_WAIT_L(n) asm volatile("s_waitcnt lgkmcnt(" #n ")" ::: "memory")
#define PG8_BAR __builtin_amdgcn_s_barrier()
#define PG8_SCHED __builtin_amdgcn_sched_barrier(0)
    Unit cur, nxt; int ui = 0;
    if (!S.next(0, cur)) return;
    f32x4 acc[2][2][4][2];
#pragma unroll
    for (int a = 0; a < 2; ++a)
#pragma unroll
        for (int b = 0; b < 2; ++b)
#pragma unroll
            for (int m = 0; m < 4; ++m)
#pragma unroll
                for (int n = 0; n < 2; ++n) acc[a][b][m][n] = (f32x4){0.f, 0.f, 0.f, 0.f};
    bf16x8 At[4][2], B0[2][2], B1[2][2];
    const char* cA = (const char*)g.A + (size_t)cur.pm * tstep; const char* cB = (const char*)g.Bt + (size_t)cur.pn * tstep;
    S.a_ready(cur);
    if constexpr (SP2) {
        PG8_STAGE(PG8_SB(0, 0), cB, voffB); PG8_STAGE(PG8_SB(0, 1), cB + hstep, voffB); PG8_STAGE(PG8_SA(0, 0), cA, voffA); PG8_STAGE(PG8_SA(0, 1), cA + hstep, voffA);
        if (wr == 1) PG8_BAR;
        PG8_WAIT_V(2); PG8_BAR;
        PG8_STAGE(PG8_SB(1, 0), cB + kstep, voffB); PG8_STAGE(PG8_SA(1, 0), cA + kstep, voffA); PG8_STAGE(PG8_SB(1, 1), cB + hstep + kstep, voffB);
        PG8_WAIT_V(6); PG8_BAR;
    } else {
        PG8_STAGE(PG8_SB(0, 0), cB, voffB); PG8_STAGE(PG8_SA(0, 0), cA, voffA); PG8_STAGE(PG8_SB(0, 1), cB + hstep, voffB); PG8_STAGE(PG8_SA(0, 1), cA + hstep, voffA);
        if (wr == 1) PG8_BAR;
        PG8_WAIT_V(4); PG8_BAR;
        PG8_STAGE(PG8_SB(1, 0), cB + kstep, voffB); PG8_STAGE(PG8_SA(1, 0), cA + kstep, voffA); PG8_STAGE(PG8_SB(1, 1), cB + hstep + kstep, voffB);
        PG8_WAIT_V(6); PG8_BAR;
    }
    for (;;) {
        const bool has_next = S.next(ui + 1, nxt);
        const char* nA = has_next ? (const char*)g.A + (size_t)nxt.pm * tstep : cA; const char* nB = has_next ? (const char*)g.Bt + (size_t)nxt.pn * tstep : cB;
        for (int t = 0; t < nt; t += 2) {
            const bool last = (t == nt - 2);
            const char* a1 = cA + (size_t)(t + 1) * kstep;
            const char* a2 = last ? nA : cA + (size_t)(t + 2) * kstep; const char* b2 = last ? nB : cB + (size_t)(t + 2) * kstep;
            const char* a3 = a2 + kstep; const char* b3 = b2 + kstep;
            if (last && has_next) S.a_ready(nxt);
            if constexpr (SP2) {
            PG8_LDB(B0, 0, 0); PG8_LDB(B1, 0, 1); PG8_SCHED; PG8_LDA(At, 0, 0); PG8_STAGE(PG8_SA(1, 1), a1 + hstep, voffA);
            PG8_WAIT_V(8); PG8_WAIT_L(0); PG8_BAR; PG8_MMA(0, 0, At, B0); PG8_MMA(0, 1, At, B1); PG8_BAR; PG8_SCHED;
            PG8_LDA(At, 0, 1); PG8_STAGE(PG8_SB(0, 0), b2, voffB); PG8_STAGE(PG8_SB(0, 1), b2 + hstep, voffB); PG8_STAGE(PG8_SA(0, 0), a2, voffA);
            PG8_WAIT_V(8); PG8_WAIT_L(0); PG8_BAR; PG8_MMA(1, 0, At, B0); PG8_MMA(1, 1, At, B1); PG8_BAR; PG8_SCHED;
            PG8_LDB(B0, 1, 0); PG8_LDB(B1, 1, 1); PG8_SCHED; PG8_LDA(At, 1, 0); PG8_STAGE(PG8_SA(0, 1), a2 + hstep, voffA);
            PG8_WAIT_V(8); PG8_WAIT_L(0); PG8_BAR; PG8_MMA(0, 0, At, B0); PG8_MMA(0, 1, At, B1); PG8_BAR; PG8_SCHED;
            PG8_LDA(At, 1, 1); PG8_STAGE(PG8_SB(1, 0), b3, voffB); PG8_STAGE(PG8_SB(1, 1), b3 + hstep, voffB); PG8_STAGE(PG8_SA(1, 0), a3, voffA);
            PG8_WAIT_V(8); PG8_WAIT_L(0); PG8_BAR; PG8_MMA(1, 0, At, B0); PG8_MMA(1, 1, At, B1); PG8_BAR; PG8_SCHED;
            } else {
            PG8_LDB(B0, 0, 0); PG8_SCHED; PG8_LDA(At, 0, 0); PG8_STAGE(PG8_SA(1, 1), a1 + hstep, voffA);
            PG8_WAIT_L(8); PG8_BAR; PG8_WAIT_L(0); PG8_MMA(0, 0, At, B0); PG8_BAR; PG8_SCHED;
            PG8_LDB(B1, 0, 1); PG8_STAGE(PG8_SB(0, 0), b2, voffB);
            PG8_BAR; PG8_WAIT_L(0); PG8_MMA(0, 1, At, B1); PG8_BAR;
            PG8_LDA(At, 0, 1); PG8_STAGE(PG8_SA(0, 0), a2, voffA);
            PG8_BAR; PG8_WAIT_L(0); PG8_MMA(1, 0, At, B0); PG8_BAR; PG8_SCHED;
            PG8_STAGE(PG8_SB(0, 1), b2 + hstep, voffB);
            PG8_WAIT_V(6); PG8_BAR; PG8_MMA(1, 1, At, B1); PG8_BAR;
            PG8_LDB(B0, 1, 0); PG8_SCHED; PG8_LDA(At, 1, 0); PG8_STAGE(PG8_SA(0, 1), a2 + hstep, voffA);
            PG8_WAIT_L(8); PG8_BAR; PG8_WAIT_L(0); PG8_MMA(0, 0, At, B0); PG8_BAR; PG8_SCHED;
            PG8_LDB(B1, 1, 1); PG8_STAGE(PG8_SB(1, 0), b3, voffB);
            PG8_BAR; PG8_WAIT_L(0); PG8_MMA(0, 1, At, B1); PG8_BAR;
            PG8_LDA(At, 1, 1); PG8_STAGE(PG8_SA(1, 0), a3, voffA);
            PG8_BAR; PG8_WAIT_L(0); PG8_MMA(1, 0, At, B0); PG8_BAR; PG8_SCHED;
            PG8_STAGE(PG8_SB(1, 1), b3 + hstep, voffB);
            PG8_WAIT_V(6); PG8_BAR; PG8_MMA(1, 1, At, B1); PG8_BAR;
            }
        }
        if constexpr (ALIGN_EPI) { if (wr == 0) PG8_BAR; }
        if constexpr (!Epi::AFTER_DRAIN) { E(acc, cur, wr, wc, fr, fq); S.done(cur); }
        if (!has_next) break;
#pragma unroll
        for (int a = 0; a < 2; ++a)
#pragma unroll
            for (int b = 0; b < 2; ++b)
#pragma unroll
                for (int m = 0; m < 4; ++m)
#pragma unroll
                    for (int n = 0; n < 2; ++n) acc[a][b][m][n] = (f32x4){0.f, 0.f, 0.f, 0.f};
        cur = nxt; cA = nA; cB = nB; ++ui;
        if constexpr (ALIGN_EPI) { if (wr == 1) PG8_BAR; }
    }
    PG8_WAIT_V(0);
    if constexpr (!ALIGN_EPI) { if (wr == 0) PG8_BAR; }
    PG8_BAR;
    if constexpr (Epi::AFTER_DRAIN) { E.fused(acc, cur, wr, wc, fr, fq, lds, wid, lane); S.done(cur); }
#undef PG8_SA
#undef PG8_SB
#undef PG8_STAGE
#undef PG8_LDA
#undef PG8_LDB
#undef PG8_MMA
#undef PG8_WAIT_V
#undef PG8_WAIT_L
#undef PG8_BAR
#undef PG8_SCHED
}
}
namespace pg8 {
#define PG8_GAS __attribute__((address_space(1)))
typedef float f32x2_cv __attribute__((ext_vector_type(2))); typedef __bf16 bf16x2_cv __attribute__((ext_vector_type(2)));
__device__ __forceinline__ unsigned cvt_pk_bf16(float lo, float hi) { const f32x2_cv v = {lo, hi}; const bf16x2_cv b = __builtin_convertvector(v, bf16x2_cv); return __builtin_bit_cast(unsigned, b); }
__device__ __forceinline__ float fsigmoid(float x) { return __builtin_amdgcn_rcpf(1.0f + __builtin_amdgcn_exp2f(-1.4426950408889634f * x)); }
__device__ __forceinline__ float fsilu(float x) { return x * fsigmoid(x); }
__device__ __forceinline__ u32x4 pack8(const f32x4 a, const f32x4 b) { u32x4 w; w.x = cvt_pk_bf16(a[0], a[1]); w.y = cvt_pk_bf16(a[2], a[3]); w.z = cvt_pk_bf16(b[0], b[1]); w.w = cvt_pk_bf16(b[2], b[3]); return w; }
__device__ __forceinline__ void unpack8(const u32x4 w, f32x4& a, f32x4& b) {
    a[0] = __uint_as_float(w.x << 16); a[1] = __uint_as_float(w.x & 0xffff0000u); a[2] = __uint_as_float(w.y << 16); a[3] = __uint_as_float(w.y & 0xffff0000u);
    b[0] = __uint_as_float(w.z << 16); b[1] = __uint_as_float(w.z & 0xffff0000u); b[2] = __uint_as_float(w.w << 16); b[3] = __uint_as_float(w.w & 0xffff0000u); }

struct EpiSwiGLU {
    static constexpr bool PERM = true, AFTER_DRAIN = false;
    bf16_t* H; int ldh;
    __device__ __forceinline__ void operator()(const f32x4 (&acc)[2][2][4][2], const Unit& u, int wr, int wc, int fr, int fq) const {
        const int row0 = u.pm * BM + wr * 64 + fr, col0 = u.pn * HALF + wc * 32 + 8 * fq;
#pragma unroll
        for (int ai = 0; ai < 2; ++ai)
#pragma unroll
            for (int m = 0; m < 4; ++m) { bf16_t* rowp = H + (size_t)(row0 + ai * HALF + m * 16) * ldh + col0;
                f32x4 v0, v1;
#pragma unroll
                for (int e = 0; e < 4; ++e) { v0[e] = fsilu(acc[ai][0][m][0][e]) * acc[ai][1][m][0][e]; v1[e] = fsilu(acc[ai][0][m][1][e]) * acc[ai][1][m][1][e]; }
                *(PG8_GAS u32x4*)rowp = pack8(v0, v1); }
    }
};
struct EpiRes {
    static constexpr bool PERM = false, AFTER_DRAIN = false;
    const float* xin; float* xout; const float* gate; int gstride; float coef;
    __device__ __forceinline__ void operator()(const f32x4 (&acc)[2][2][4][2], const Unit& u, int wr, int wc, int fr, int fq) const {
        const int row0 = u.pm * BM + wr * 64 + fr, col0 = u.pn * BM + wc * 32 + 4 * fq;
        const float* g = gate + (u.pm >= 32 ? gstride : 0);
        f32x4 gv[2][2];
#pragma unroll
        for (int bj = 0; bj < 2; ++bj)
#pragma unroll
            for (int n = 0; n < 2; ++n) gv[bj][n] = *(const PG8_GAS f32x4*)(g + col0 + bj * HALF + n * 16) * coef;
#pragma unroll
        for (int ai = 0; ai < 2; ++ai)
#pragma unroll
            for (int m = 0; m < 4; ++m) { const size_t off = (size_t)(row0 + ai * HALF + m * 16) * 1024 + col0;
#pragma unroll
                for (int bj = 0; bj < 2; ++bj)
#pragma unroll
                    for (int n = 0; n < 2; ++n) { const f32x4 xi = *(const PG8_GAS f32x4*)(xin + off + bj * HALF + n * 16); *(PG8_GAS f32x4*)(xout + off + bj * HALF + n * 16) = xi + gv[bj][n] * acc[ai][bj][m][n]; } }
    }
};
template <int SECOND> struct EpiMerge {
    static constexpr bool PERM = true, AFTER_DRAIN = false;
    const bf16_t* G; const bf16_t* T; bf16_t* O;
    __device__ __forceinline__ void operator()(const f32x4 (&acc)[2][2][4][2], const Unit& u, int wr, int wc, int fr, int fq) const {
        const int row0 = u.pm * BM + wr * 64 + fr, col0 = u.pn * BM + wc * 32 + 8 * fq;
#pragma unroll
        for (int ai = 0; ai < 2; ++ai)
#pragma unroll
            for (int m = 0; m < 4; ++m) { const size_t off = (size_t)(row0 + ai * HALF + m * 16) * 1024 + col0;
#pragma unroll
                for (int bj = 0; bj < 2; ++bj) { f32x4 g0, g1; unpack8(*(const PG8_GAS u32x4*)(G + off + bj * HALF), g0, g1);
                    f32x4 v0 = g0 * acc[ai][bj][m][0], v1 = g1 * acc[ai][bj][m][1];
                    if (SECOND) { f32x4 t0, t1; unpack8(*(const PG8_GAS u32x4*)(T + off + bj * HALF), t0, t1); v0 += t0; v1 += t1; }
                    *(PG8_GAS u32x4*)(O + off + bj * HALF) = pack8(v0, v1); } }
    }
};
struct EpiProj {
    static constexpr bool PERM = true, AFTER_DRAIN = false;
    bf16_t *RQ, *RK, *RV, *RG, *SQ, *SK, *SV, *GR, *GS; const float *cosr, *sinr, *coss, *sins;
    __device__ __forceinline__ void operator()(const f32x4 (&acc)[2][2][4][2], const Unit& u, int wr, int wc, int fr, int fq) const {
        const int pn = u.pn, row0 = u.pm * BM + wr * 64 + fr, j0 = wc * 32 + 8 * fq;
        if (pn < 4) {
            const bool isq = pn < 2; const int head = 2 * (pn & 1) + (wc >> 1), i0 = j0 & 63;
            bf16_t* O = isq ? RQ : RK;
            const float lg = __log2f(1.0f - __builtin_amdgcn_exp2f(-5.0f - (float)head)) * (isq ? 1.0f : -1.0f);
            const float sc = isq ? 0.08838834764831845f : 1.0f;
#pragma unroll
            for (int ai = 0; ai < 2; ++ai)
#pragma unroll
                for (int m = 0; m < 4; ++m) { const int row = row0 + ai * HALF + m * 16; const float dec = __builtin_amdgcn_exp2f((float)(row & 127) * lg) * sc;
                    f32x4 o1[2], o2[2];
#pragma unroll
                    for (int n = 0; n < 2; ++n) { const f32x4 c = *(const PG8_GAS f32x4*)(cosr + (size_t)row * 64 + i0 + 4 * n), s = *(const PG8_GAS f32x4*)(sinr + (size_t)row * 64 + i0 + 4 * n);
                        const f32x4 x1 = acc[ai][0][m][n], x2 = acc[ai][1][m][n]; o1[n] = (x1 * c - x2 * s) * dec; o2[n] = (x2 * c + x1 * s) * dec; }
                    bf16_t* p = O + (size_t)row * 512 + head * 128 + i0; *(PG8_GAS u32x4*)p = pack8(o1[0], o1[1]); *(PG8_GAS u32x4*)(p + 64) = pack8(o2[0], o2[1]); asm volatile("" ::: "memory"); }
        } else if (pn < 12) {
            const bool isg = pn >= 8; bf16_t* O = isg ? RG : RV; const int colt = ((pn - 4) & 3) * 256 + j0;
#pragma unroll
            for (int ai = 0; ai < 2; ++ai)
#pragma unroll
                for (int m = 0; m < 4; ++m) { const int row = row0 + ai * HALF + m * 16;
#pragma unroll
                    for (int bj = 0; bj < 2; ++bj) { f32x4 v0 = acc[ai][bj][m][0], v1 = acc[ai][bj][m][1];
                        if (isg) {
#pragma unroll
                            for (int e = 0; e < 4; ++e) { v0[e] = fsilu(v0[e]); v1[e] = fsilu(v1[e]); } }
                        *(PG8_GAS u32x4*)(O + (size_t)row * 1024 + colt + bj * HALF) = pack8(v0, v1); } }
        } else if (pn < 16 || (pn == 16 && wc < 2)) {
            const bool isq = pn < 16; const int head = isq ? 4 * (pn - 12) + wc : wc, i0 = 8 * fq;
            bf16_t* O = isq ? SQ : SK; const int ld = isq ? 1024 : 128; const float sc = isq ? 0.125f : 1.0f;
#pragma unroll
            for (int ai = 0; ai < 2; ++ai)
#pragma unroll
                for (int m = 0; m < 4; ++m) { const int row = row0 + ai * HALF + m * 16;
                    f32x4 o1[2], o2[2];
#pragma unroll
                    for (int n = 0; n < 2; ++n) { const f32x4 c = *(const PG8_GAS f32x4*)(coss + (size_t)row * 32 + i0 + 4 * n), s = *(const PG8_GAS f32x4*)(sins + (size_t)row * 32 + i0 + 4 * n);
                        const f32x4 x1 = acc[ai][0][m][n], x2 = acc[ai][1][m][n]; o1[n] = (x1 * c - x2 * s) * sc; o2[n] = (x2 * c + x1 * s) * sc; }
                    bf16_t* p = O + (size_t)row * ld + head * 64 + i0; *(PG8_GAS u32x4*)p = pack8(o1[0], o1[1]); *(PG8_GAS u32x4*)(p + 32) = pack8(o2[0], o2[1]); asm volatile("" ::: "memory"); }
        } else if (pn == 16) {
            const int jj = (wc - 2) * 32 + 8 * fq;
#pragma unroll
            for (int ai = 0; ai < 2; ++ai)
#pragma unroll
                for (int m = 0; m < 4; ++m) { const int row = row0 + ai * HALF + m * 16;
#pragma unroll
                    for (int bj = 0; bj < 2; ++bj) *(PG8_GAS u32x4*)(SV + (size_t)row * 128 + bj * 64 + jj) = pack8(acc[ai][bj][m][0], acc[ai][bj][m][1]); }
        } else {
            bf16_t* O = pn >= 21 ? GS : GR; const int colt = ((pn - 17) & 3) * 256 + j0;
#pragma unroll
            for (int ai = 0; ai < 2; ++ai)
#pragma unroll
                for (int m = 0; m < 4; ++m) { const int row = row0 + ai * HALF + m * 16;
#pragma unroll
                    for (int bj = 0; bj < 2; ++bj) { f32x4 v0 = acc[ai][bj][m][0], v1 = acc[ai][bj][m][1];
#pragma unroll
#ifndef DBG_RAW_GATES
                        for (int e = 0; e < 4; ++e) { v0[e] = fsigmoid(v0[e]); v1[e] = fsigmoid(v1[e]); }
#else
                        for (int e = 0; e < 4; ++e) { v0[e] = v0[e] * 0.25f; v1[e] = v1[e] * 0.25f; }
#endif
                        *(PG8_GAS u32x4*)(O + (size_t)row * 1024 + colt + bj * HALF) = pack8(v0, v1); } }
        }
    }
};
}
#define GAS __attribute__((address_space(1)))
#define LAS __attribute__((address_space(3)))
typedef unsigned short bf16;
typedef unsigned v4u __attribute__((ext_vector_type(4)));
typedef float f32x4 __attribute__((ext_vector_type(4)));
typedef short bf16x8 __attribute__((ext_vector_type(8)));
typedef GAS unsigned gu32;
typedef GAS unsigned long long gu64;
#define RLX_AGENT __ATOMIC_RELAXED, __HIP_MEMORY_SCOPE_AGENT
#define LDS_WAIT() asm volatile("s_waitcnt lgkmcnt(0)" ::: "memory")
#define VM_WAIT() asm volatile("s_waitcnt vmcnt(0)" ::: "memory")
__device__ __forceinline__ unsigned long long rt() { return __builtin_amdgcn_s_memrealtime(); }
__device__ __forceinline__ unsigned f2bf(float f) { unsigned u = __builtin_bit_cast(unsigned, f); return (u + 0x7fffu + ((u >> 16) & 1u)) >> 16; }
__device__ __forceinline__ unsigned pk2(float lo, float hi) { return f2bf(lo) | (f2bf(hi) << 16); }

#define XB_TMO      128
#define XB_XCNT(j)  (256  + 64 * (j))
#define XB_XSUB(j)  (1280 + 64 * (j))
#define XB_XGEN(j)  (2304 + 64 * (j))
#define XB_TOP      3328
#define XB_TOPGEN   3392
#define XCD_BAR_WORDS 3456
#define XB_SPIN_CAP (1u << 18)

__device__ __forceinline__ unsigned xb_ld(unsigned* p)              { return __hip_atomic_load(p, __ATOMIC_RELAXED, __HIP_MEMORY_SCOPE_AGENT); }
__device__ __forceinline__ unsigned xb_add(unsigned* p, unsigned v) { return __hip_atomic_fetch_add(p, v, __ATOMIC_RELAXED, __HIP_MEMORY_SCOPE_AGENT); }
__device__ __forceinline__ unsigned xb_xcc_id() { return (unsigned)__builtin_amdgcn_s_getreg((3 << 11) | 20) & 0xFu; }
#define XB_SPIN(cond, bar) do { unsigned _sp = 0; while (cond) { __builtin_amdgcn_s_sleep(1); \
    if ((++_sp & 255u) == 0u) { if (xb_ld(&(bar)[XB_TMO])) break; if (_sp > XB_SPIN_CAP) { atomicAdd(&(bar)[XB_TMO], 1u); break; } } } } while (0)

struct XcdBarrier {
    unsigned* bar; unsigned x;
    volatile LAS unsigned* st;
};

__device__ __forceinline__ XcdBarrier xcd_barrier_post(unsigned* bar, volatile LAS unsigned* st) {
    XcdBarrier b; b.bar = bar; b.x = xb_xcc_id(); b.st = st;
    if (threadIdx.x == 0) (void)xb_add(&bar[XB_XCNT(b.x)], 1u);
    return b;
}
__device__ __forceinline__ void xcd_barrier_complete(unsigned* bar, unsigned x, unsigned& nloc, unsigned& nx) {
    const unsigned G = gridDim.x * gridDim.y * gridDim.z;
    unsigned sum, cnt, mine, sp = 0u;
    for (;;) {
        sum = 0u; cnt = 0u; mine = 0u;
#pragma unroll
        for (unsigned j = 0; j < 16; ++j) { const unsigned c = xb_ld(&bar[XB_XCNT(j)]); sum += c; cnt += (c > 0u) ? 1u : 0u; mine = (j == x) ? c : mine; }
        if (sum == G) break;
        __builtin_amdgcn_s_sleep(1);
        if ((++sp & 255u) == 0u) { if (xb_ld(&bar[XB_TMO])) break; if (sp > XB_SPIN_CAP) { atomicAdd(&bar[XB_TMO], 1u); break; } }
    }
    nloc = mine > 0u ? mine : 1u; nx = cnt > 0u ? cnt : 1u;
}

__device__ __forceinline__ void xcd_barrier(const XcdBarrier& b) {
    asm volatile("s_waitcnt vmcnt(0)" ::: "memory");
    __syncthreads();
    if (threadIdx.x == 0) {
        unsigned* bar = b.bar;
        __builtin_amdgcn_s_waitcnt(0);
        unsigned nloc = b.st[0], nx = b.st[1];
        if (nloc == 0u) { xcd_barrier_complete(bar, b.x, nloc, nx); b.st[0] = nloc; b.st[1] = nx; }
        const unsigned old = xb_add(&bar[XB_XSUB(b.x)], 1u);
        const unsigned gen = old / nloc;
        if (old + 1u == (gen + 1u) * nloc) {
            __builtin_amdgcn_fence(__ATOMIC_RELEASE, "agent");
            asm volatile("s_waitcnt vmcnt(0)" ::: "memory");
            const unsigned og = xb_add(&bar[XB_TOP], 1u);
            const unsigned tg = og / nx;
            if (og + 1u == (tg + 1u) * nx) xb_add(&bar[XB_TOPGEN], 1u);
            else XB_SPIN(xb_ld(&bar[XB_TOPGEN]) == tg, bar);
            __builtin_amdgcn_fence(__ATOMIC_ACQUIRE, "agent");
            xb_add(&bar[XB_XGEN(b.x)], 1u);
            asm volatile("s_waitcnt vmcnt(0)" ::: "memory");
        } else {
            XB_SPIN(xb_ld(&bar[XB_XGEN(b.x)]) == gen, bar);
            __builtin_amdgcn_fence(__ATOMIC_ACQUIRE, "agent");
            asm volatile("s_waitcnt vmcnt(0)" ::: "memory");
        }
    }
    __syncthreads();
}
constexpr int NWAVES = 8, NTHREADS = 512;
#ifndef MK_ONE_LAUNCH
#define MK_ONE_LAUNCH 0
#endif
#ifndef EN_FFN1
#define EN_FFN1 1
#endif
#ifndef EN_MIX
#define EN_MIX 1
#endif
#ifndef EN_FFN2
#define EN_FFN2 1
#endif
constexpr int BATCH = 2, T = 8192, D = 1024, M = BATCH * T, FF = 2816, NUP = 2 * FF, NIN = 6400, NMOD = 9 * D, DEPTH = 2;
constexpr float NORM_EPS = 1e-6f;
constexpr size_t MiB = 1u << 20;
constexpr size_t WS_CTL = 0, CTL_ZERO_BYTES = 64 * 1024;
constexpr size_t WS_MOD = 1 * MiB;
constexpr size_t WS_COSR = 2 * MiB, WS_SINR = 6 * MiB;
constexpr size_t WS_COSS = 10 * MiB, WS_SINS = 12 * MiB;
constexpr size_t WS_WUP1 = 14 * MiB, WS_WDN1 = 25 * MiB, WS_WIN = WS_WDN1 + 5767168, WS_WBR = 43 * MiB, WS_WBS = 45 * MiB, WS_WOUT = 47 * MiB, WS_WUP2 = 49 * MiB, WS_WDN2 = 60 * MiB;
constexpr size_t WS_XN = 66 * MiB;
constexpr size_t WS_RQ = 98 * MiB, WS_RK = 114 * MiB, WS_RV = 130 * MiB, WS_RG = 162 * MiB, WS_SQ = 194 * MiB, WS_SK = 226 * MiB, WS_SV = 230 * MiB, WS_GR = 234 * MiB, WS_GS = 266 * MiB;
constexpr size_t WS_H = 98 * MiB;
constexpr size_t WS_TMP = 98 * MiB;
constexpr size_t WS_KV = 298 * MiB;
constexpr size_t WS_END = 330 * MiB;
static_assert(WS_WIN + (size_t)NIN * D * 2 <= WS_WBR && WS_WDN2 + (size_t)D * FF * 2 <= WS_XN && WS_H + (size_t)M * FF * 2 <= WS_KV, "ws map");
constexpr int CW_BAR = 1024;
constexpr int LDS_BYTES = 147456, MISC_OFF = 140 * 1024;

struct Frame { LAS unsigned char* lds; int tid, lane, wave, vcu, G; };

__device__ __forceinline__ float wave_sum(float v) {
#pragma unroll
    for (int o = 1; o < 64; o <<= 1) v += __shfl_xor(v, o);
    return v;
}
__device__ __forceinline__ float lg2gamma(int h) { return __log2f(1.0f - __builtin_amdgcn_exp2f(-5.0f - (float)h)); }
__device__ __forceinline__ float bf2f(unsigned short b) { return __uint_as_float((unsigned)b << 16); }

__device__ __forceinline__ void conv_item(const float* W, int ldw, int k0, int n0src, bf16* WT, int ldk, int drow0, LAS float* scr, int lane) {
#pragma unroll 8
    for (int i = 0; i < 32; ++i) { const int kk = 2 * i + (lane >> 5); scr[kk * 33 + (lane & 31)] = ((const GAS float*)W)[(size_t)(k0 + kk) * ldw + n0src + (lane & 31)]; }
    LDS_WAIT(); asm volatile("" ::: "memory");
    const int c = lane & 7;
#pragma unroll
    for (int j = 0; j < 4; ++j) { const int n = (lane >> 3) + 8 * j; const LAS float* s = scr + (8 * c) * 33 + n;
        v4u o; o.x = pk2(s[0 * 33], s[1 * 33]); o.y = pk2(s[2 * 33], s[3 * 33]); o.z = pk2(s[4 * 33], s[5 * 33]); o.w = pk2(s[6 * 33], s[7 * 33]);
        *(GAS v4u*)(WT + (size_t)(drow0 + n) * ldk + k0 + 8 * c) = o; }
    LDS_WAIT(); asm volatile("" ::: "memory");
}
__device__ __forceinline__ int map_up(int g) { const int c = 32 * g, pn = c >> 8, bj = (c >> 7) & 1, j = c & 127; return bj * FF + 128 * pn + j; }
__device__ __forceinline__ int map_in(int g) {
    const int c = 32 * g, pn = c >> 8, bj = (c >> 7) & 1, j = c & 127;
    if (pn < 2)  return 0    + (2 * pn + (j >> 6)) * 128 + bj * 64 + (j & 63);
    if (pn < 4)  return 512  + (2 * (pn - 2) + (j >> 6)) * 128 + bj * 64 + (j & 63);
    if (pn < 8)  return 1024 + (pn - 4) * 256 + bj * 128 + j;
    if (pn < 12) return 2048 + (pn - 8) * 256 + bj * 128 + j;
    if (pn < 16) return 3072 + (4 * (pn - 12) + (j >> 5)) * 64 + bj * 32 + (j & 31);
    if (pn == 16) return j < 64 ? 4096 + (j >> 5) * 64 + bj * 32 + (j & 31) : 4224 + bj * 64 + (j - 64);
    if (pn < 21) return 4352 + (pn - 17) * 256 + bj * 128 + j;
    return 5376 + (pn - 21) * 256 + bj * 128 + j;
}
struct LayerW { const float *up1, *dn1, *win, *wbr, *wbs, *wout, *up2, *dn2; };
__device__ __forceinline__ void conv_phase(Frame& F, const LayerW& W, unsigned char* ws) {
    LAS float* scr = (LAS float*)(F.lds + F.wave * 16384);
    const int gw = F.vcu * NWAVES + F.wave, NGW = F.G * NWAVES;
    constexpr int I_UP = 16 * 176, I_DN = 44 * 32, I_IN = 16 * 200, I_SQ = 16 * 32;
    constexpr int NITEMS = 2 * I_UP + 2 * I_DN + I_IN + 3 * I_SQ;
    for (int it = gw; it < NITEMS; it += NGW) {
        int r = it;
        if (r < I_UP) { const int kb = r / 176, g = r % 176; conv_item(W.up1, NUP, 64 * kb, map_up(g), (bf16*)(ws + WS_WUP1), D, 32 * g, scr, F.lane); continue; } r -= I_UP;
        if (r < I_UP) { const int kb = r / 176, g = r % 176; conv_item(W.up2, NUP, 64 * kb, map_up(g), (bf16*)(ws + WS_WUP2), D, 32 * g, scr, F.lane); continue; } r -= I_UP;
        if (r < I_DN) { const int kb = r / 32, g = r % 32; conv_item(W.dn1, D, 64 * kb, 32 * g, (bf16*)(ws + WS_WDN1), FF, 32 * g, scr, F.lane); continue; } r -= I_DN;
        if (r < I_DN) { const int kb = r / 32, g = r % 32; conv_item(W.dn2, D, 64 * kb, 32 * g, (bf16*)(ws + WS_WDN2), FF, 32 * g, scr, F.lane); continue; } r -= I_DN;
        if (r < I_IN) { const int kb = r / 200, g = r % 200; conv_item(W.win, NIN, 64 * kb, map_in(g), (bf16*)(ws + WS_WIN), D, 32 * g, scr, F.lane); continue; } r -= I_IN;
        if (r < I_SQ) { const int kb = r / 32, g = r % 32; conv_item(W.wbr, D, 64 * kb, 32 * g, (bf16*)(ws + WS_WBR), D, 32 * g, scr, F.lane); continue; } r -= I_SQ;
        if (r < I_SQ) { const int kb = r / 32, g = r % 32; conv_item(W.wbs, D, 64 * kb, 32 * g, (bf16*)(ws + WS_WBS), D, 32 * g, scr, F.lane); continue; } r -= I_SQ;
        { const int kb = r / 32, g = r % 32; conv_item(W.wout, D, 64 * kb, 32 * g, (bf16*)(ws + WS_WOUT), D, 32 * g, scr, F.lane); }
    }
}
__device__ __forceinline__ void mod_rope_phase(Frame& F, const float* c, const float* w_ada, const float* b_ada, const int* positions, unsigned char* ws) {
    LAS float* cact = (LAS float*)(F.lds);
    LAS float* red = (LAS float*)(F.lds + 8192);
    float* MOD = (float*)(ws + WS_MOD);
    for (int t = F.tid; t < 2 * D; t += NTHREADS) { const float v = ((const GAS float*)c)[t]; cact[t] = v / (1.0f + __expf(-v)); }
    __syncthreads();
    for (int item = F.vcu; item < 256; item += F.G) {
        const int l = item >> 7, n0 = (item & 127) * 72, kg = F.tid / 18, cl = F.tid % 18;
        f32x4 a0 = {0.f, 0.f, 0.f, 0.f}, a1 = {0.f, 0.f, 0.f, 0.f};
        if (F.tid < 504) {
            const float* wp = w_ada + (size_t)l * D * NMOD + n0 + 4 * cl;
#pragma unroll 4
            for (int k = kg; k < D; k += 28) { const f32x4 w = *(const GAS f32x4*)(wp + (size_t)k * NMOD); a0 += w * cact[k]; a1 += w * cact[D + k]; }
            LAS float* rp = red + (kg * 18 + cl) * 8;
#pragma unroll
            for (int e = 0; e < 4; ++e) { rp[e] = a0[e]; rp[4 + e] = a1[e]; }
        }
        __syncthreads();
        if (F.tid < 144) { const int cl2 = F.tid >> 3, comp = F.tid & 7, b = comp >> 2, e = comp & 3; float s = 0.f;
            for (int g = 0; g < 28; ++g) s += red[(g * 18 + cl2) * 8 + comp];
            ((GAS float*)MOD)[(size_t)(l * 2 + b) * NMOD + n0 + 4 * cl2 + e] = s + ((const GAS float*)b_ada)[(size_t)l * NMOD + n0 + 4 * cl2 + e]; }
        __syncthreads();
    }
    GAS float* cosr = (GAS float*)(ws + WS_COSR); GAS float* sinr = (GAS float*)(ws + WS_SINR); GAS float* coss = (GAS float*)(ws + WS_COSS); GAS float* sins = (GAS float*)(ws + WS_SINS);
    const int gt = F.vcu * NTHREADS + F.tid, NGT = F.G * NTHREADS;
    for (int idx = gt; idx < M * 64; idx += NGT) {
        const int row = idx >> 6, i = idx & 63; const float pos = (float)((const GAS int*)positions)[row];
        const float inv = (float)exp2(-(double)i * (13.287712379549449 / 64.0));
        const double a = (double)(pos * inv), n = rint(a * 0.15915494309189535), r = a - n * 6.283185307179586;
        const float rf = (float)r; cosr[idx] = cosf(rf); sinr[idx] = sinf(rf);
        if (!(i & 1)) { const int o = row * 32 + (i >> 1); coss[o] = cosf(rf); sins[o] = sinf(rf); }
    }
}
__device__ __forceinline__ void norm_phase(Frame& F, const float* xin, const float* gain, const float* shift, const float* scale, bf16* XN) {
    const int gw = F.vcu * NWAVES + F.wave, NGW = F.G * NWAVES;
    const GAS f32x4* g4 = (const GAS f32x4*)gain + F.lane;
    for (int m = gw; m < M; m += NGW) {
        const GAS f32x4* xr = (const GAS f32x4*)(xin + (size_t)m * D) + F.lane;
        f32x4 v[4]; float s = 0.f;
#pragma unroll
        for (int j = 0; j < 4; ++j) { v[j] = xr[64 * j]; s += (v[j].x * v[j].x + v[j].y * v[j].y) + (v[j].z * v[j].z + v[j].w * v[j].w); }
        const float rstd = 1.0f / sqrtf(wave_sum(s) * (1.0f / D) + NORM_EPS);
        const int bo = (m >= T) ? NMOD : 0;
        const GAS f32x4* sh4 = (const GAS f32x4*)(shift + bo) + F.lane; const GAS f32x4* sc4 = (const GAS f32x4*)(scale + bo) + F.lane;
        GAS unsigned long long* o8 = (GAS unsigned long long*)(XN + (size_t)m * D) + F.lane;
#pragma unroll
        for (int j = 0; j < 4; ++j) { const f32x4 o = (v[j] * rstd) * g4[64 * j] * (sc4[64 * j] + 1.0f) + sh4[64 * j];
            o8[64 * j] = (unsigned long long)pk2(o.x, o.y) | ((unsigned long long)pk2(o.z, o.w) << 32); }
    }
}
__device__ __forceinline__ void final_norm_phase(Frame& F, float* x, const float* gain) {
    const int gw = F.vcu * NWAVES + F.wave, NGW = F.G * NWAVES;
    const GAS f32x4* g4 = (const GAS f32x4*)gain + F.lane;
    for (int m = gw; m < M; m += NGW) {
        GAS f32x4* xr = (GAS f32x4*)(x + (size_t)m * D) + F.lane;
        f32x4 v[4]; float s = 0.f;
#pragma unroll
        for (int j = 0; j < 4; ++j) { v[j] = xr[64 * j]; s += (v[j].x * v[j].x + v[j].y * v[j].y) + (v[j].z * v[j].z + v[j].w * v[j].w); }
        const float rstd = 1.0f / sqrtf(wave_sum(s) * (1.0f / D) + NORM_EPS);
#pragma unroll
        for (int j = 0; j < 4; ++j) xr[64 * j] = (v[j] * rstd) * g4[64 * j];
    }
}
typedef short s16x4 __attribute__((ext_vector_type(4)));
typedef unsigned v2u __attribute__((ext_vector_type(2)));
#define MFMA16(x, y, c) __builtin_amdgcn_mfma_f32_16x16x32_bf16((x), (y), (c), 0, 0, 0)
__device__ __forceinline__ s16x4 tr_read(LAS const unsigned char* p) { return __builtin_bit_cast(s16x4, __builtin_amdgcn_ds_read_tr16_b64_v4i16((LAS s16x4*)p)); }
__device__ __forceinline__ bf16x8 frag_nat(LAS const unsigned char* base, int RS, int r0, int k0, int lane) { return *(LAS const bf16x8*)(base + (r0 + (lane & 15)) * RS + (k0 + 8 * (lane >> 4)) * 2); }
__device__ __forceinline__ bf16x8 frag_tr(LAS const unsigned char* base, int RS, int klo, int khi, int c0, int lane) {
    const int i = lane & 15, q = i >> 2, p = i & 3;
    const s16x4 lo = tr_read(base + (klo + q) * RS + (c0 + 4 * p) * 2), hi = tr_read(base + (khi + q) * RS + (c0 + 4 * p) * 2);
    return (bf16x8){lo[0], lo[1], lo[2], lo[3], hi[0], hi[1], hi[2], hi[3]};
}
__device__ __forceinline__ void stage_tile(LAS unsigned char* dst, int RS, const bf16* src, size_t gstride, int rows, int cpr_log2, int tid) {
    const int total = rows << cpr_log2;
    for (int c = tid; c < total; c += NTHREADS) { const int r = c >> cpr_log2, cc = c & ((1 << cpr_log2) - 1);
        const v4u v = *(const GAS v4u*)(src + (size_t)r * gstride + cc * 8); *(LAS v4u*)(dst + r * RS + cc * 16) = v; }
}
__device__ __forceinline__ unsigned pkbf(float lo, float hi) { return pg8::cvt_pk_bf16(lo, hi); }

constexpr int RS_QK = 272, RS_V = 528;
__device__ __forceinline__ void kv_unit(Frame& F, int u, const bf16* RK, const bf16* RV, bf16* KV) {
    const int b = u >> 8, n = (u >> 2) & 63, h = u & 3, lane = F.lane, w = F.wave, i = lane & 15, g = lane >> 4;
    const size_t row0 = (size_t)b * T + n * 128;
    LAS unsigned char* Ks = F.lds; LAS unsigned char* Vs = F.lds + 128 * RS_QK;
    stage_tile(Ks, RS_QK, RK + row0 * 512 + h * 128, 512, 128, 4, F.tid);
    stage_tile(Vs, RS_V, RV + row0 * 1024 + h * 256, 1024, 128, 5, F.tid);
    __syncthreads();
    f32x4 acc[16];
#pragma unroll
    for (int t = 0; t < 16; ++t) acc[t] = (f32x4){0.f, 0.f, 0.f, 0.f};
#pragma unroll
    for (int s = 0; s < 4; ++s) {
        const bf16x8 y = frag_tr(Ks, RS_QK, 32 * s + 8 * g, 32 * s + 8 * g + 4, 16 * w, lane);
#pragma unroll
        for (int t = 0; t < 16; ++t) { const bf16x8 x = frag_tr(Vs, RS_V, 32 * s + 8 * g, 32 * s + 8 * g + 4, 16 * t, lane); acc[t] = MFMA16(x, y, acc[t]); }
    }
    const float sc = __builtin_amdgcn_exp2f(127.0f * lg2gamma(h));
    bf16* o = KV + (size_t)u * 32768 + (16 * w + i) * 256 + 4 * g;
#pragma unroll
    for (int t = 0; t < 16; ++t) { const f32x4 v = acc[t] * sc; *(GAS v2u*)(o + 16 * t) = (v2u){pkbf(v[0], v[1]), pkbf(v[2], v[3])}; }
    __syncthreads();
}
__device__ __forceinline__ void scan_phase(Frame& F, bf16* KV) {
    const int gt = F.vcu * NTHREADS + F.tid, NGT = F.G * NTHREADS;
    for (int idx = gt; idx < 8 * 16384; idx += NGT) {
        const int bh = idx >> 14, e2 = idx & 16383, b = bh >> 2, h = bh & 3;
        GAS unsigned* p = (GAS unsigned*)(KV + ((size_t)(b * 64) * 4 + h) * 32768) + e2;
        const float dec = __builtin_amdgcn_exp2f(128.0f * lg2gamma(h));
        float s0 = 0.f, s1 = 0.f;
#pragma unroll 8
        for (int n = 0; n < 64; ++n) { const unsigned v = p[(size_t)n * 65536];
            p[(size_t)n * 65536] = pkbf(s0, s1);
            s0 = dec * s0 + __uint_as_float(v << 16); s1 = dec * s1 + __uint_as_float(v & 0xffff0000u); }
    }
}
__device__ __forceinline__ void ret_unit(Frame& F, int u, const bf16* RQ, const bf16* RK, bf16* RV, const bf16* RG, const bf16* KV) {
    const int b = u >> 8, n = (u >> 2) & 63, h = u & 3, lane = F.lane, w = F.wave, i = lane & 15, g = lane >> 4;
    const size_t row0 = (size_t)b * T + n * 128;
    LAS unsigned char* Qs = F.lds; LAS unsigned char* Ks = F.lds + 128 * RS_QK; LAS unsigned char* Rs = F.lds + 256 * RS_QK;
    stage_tile(Qs, RS_QK, RQ + row0 * 512 + h * 128, 512, 128, 4, F.tid);
    stage_tile(Ks, RS_QK, RK + row0 * 512 + h * 128, 512, 128, 4, F.tid);
    stage_tile(Rs, RS_V, KV + (size_t)u * 32768, 256, 128, 5, F.tid);
    __syncthreads();
    f32x4 acc[16];
#pragma unroll
    for (int t = 0; t < 16; ++t) acc[t] = (f32x4){0.f, 0.f, 0.f, 0.f};
    bf16x8 yq[4];
#pragma unroll
    for (int s = 0; s < 4; ++s) yq[s] = frag_nat(Qs, RS_QK, 16 * w, 32 * s, lane);
#pragma unroll
    for (int s = 0; s < 4; ++s)
#pragma unroll
        for (int t = 0; t < 16; ++t) { const bf16x8 x = frag_tr(Rs, RS_V, 32 * s + 8 * g, 32 * s + 8 * g + 4, 16 * t, lane); acc[t] = MFMA16(x, yq[s], acc[t]); }
    const float gam = __builtin_amdgcn_exp2f(lg2gamma(h));
#pragma unroll
    for (int t = 0; t < 16; ++t) acc[t] *= gam;
    bf16x8 pf[4];
#pragma unroll
    for (int kp = 0; kp < 4; ++kp) {
        f32x4 sa = (f32x4){0.f, 0.f, 0.f, 0.f}, sb = (f32x4){0.f, 0.f, 0.f, 0.f};
        if (2 * kp <= w) {
#pragma unroll
            for (int s = 0; s < 4; ++s) { sa = MFMA16(frag_nat(Ks, RS_QK, 32 * kp, 32 * s, lane), yq[s], sa); sb = MFMA16(frag_nat(Ks, RS_QK, 32 * kp + 16, 32 * s, lane), yq[s], sb); }
        }
        const int ti = 16 * w + i, ja = 32 * kp + 4 * g, jb = ja + 16;
#pragma unroll
        for (int r = 0; r < 4; ++r) { if (ja + r > ti) sa[r] = 0.f; if (jb + r > ti) sb[r] = 0.f; }
        const unsigned p0 = pkbf(sa[0], sa[1]), p1 = pkbf(sa[2], sa[3]), p2 = pkbf(sb[0], sb[1]), p3 = pkbf(sb[2], sb[3]);
        pf[kp] = __builtin_bit_cast(bf16x8, (v4u){p0, p1, p2, p3});
    }
    __syncthreads();
    stage_tile(Rs, RS_V, RV + row0 * 1024 + h * 256, 1024, 128, 5, F.tid);
    __syncthreads();
#pragma unroll
    for (int kp = 0; kp < 4; ++kp) {
        if (2 * kp <= w) {
#pragma unroll
            for (int t = 0; t < 16; ++t) { const bf16x8 x = frag_tr(Rs, RS_V, 32 * kp + 4 * g, 32 * kp + 16 + 4 * g, 16 * t, lane); acc[t] = MFMA16(x, pf[kp], acc[t]); }
        }
    }
    float s = 0.f;
#pragma unroll
    for (int t = 0; t < 16; ++t) s += (acc[t][0] + acc[t][1]) + (acc[t][2] + acc[t][3]);
    s += __shfl_xor(s, 16); s += __shfl_xor(s, 32);
    const float mu = s * (1.0f / 256.0f); float q = 0.f;
#pragma unroll
    for (int t = 0; t < 16; ++t) { const f32x4 d = acc[t] - mu; q += (d[0] * d[0] + d[1] * d[1]) + (d[2] * d[2] + d[3] * d[3]); }
    q += __shfl_xor(q, 16); q += __shfl_xor(q, 32);
    const float rstd = 1.0f / sqrtf(q * (1.0f / 256.0f) + NORM_EPS);
    const size_t ob = (row0 + 16 * w + i) * 1024 + h * 256 + 4 * g;
#pragma unroll
    for (int t = 0; t < 16; ++t) { const v2u gz = *(const GAS v2u*)(RG + ob + 16 * t);
        const float o0 = (acc[t][0] - mu) * rstd * __uint_as_float(gz.x << 16), o1 = (acc[t][1] - mu) * rstd * __uint_as_float(gz.x & 0xffff0000u);
        const float o2 = (acc[t][2] - mu) * rstd * __uint_as_float(gz.y << 16), o3 = (acc[t][3] - mu) * rstd * __uint_as_float(gz.y & 0xffff0000u);
        *(GAS v2u*)(RV + ob + 16 * t) = (v2u){pkbf(o0, o1), pkbf(o2, o3)}; }
    __syncthreads();
}
constexpr int RS_S = 144;
__device__ __forceinline__ void swa_unit(Frame& F, int u, bf16* SQ, const bf16* SK, const bf16* SV, const float* sinks) {
    const int b = u >> 7, n = (u >> 1) & 63, kvh = u & 1, lane = F.lane, w = F.wave, i = lane & 15, g = lane >> 4;
    LAS unsigned char* Ks = F.lds; LAS unsigned char* Vs = F.lds + 272 * RS_S;
    for (int c = F.tid; c < 272 * 8; c += NTHREADS) { const int r = c >> 3, cc = c & 7;
        v4u kv = (v4u){0u, 0u, 0u, 0u}, vv = kv;
        if (r < 256 && (n > 0 || r >= 128)) { const size_t tok = (size_t)b * T + (n - 1) * 128 + r; kv = *(const GAS v4u*)(SK + tok * 128 + kvh * 64 + cc * 8); vv = *(const GAS v4u*)(SV + tok * 128 + kvh * 64 + cc * 8); }
        *(LAS v4u*)(Ks + r * RS_S + cc * 16) = kv; *(LAS v4u*)(Vs + r * RS_S + cc * 16) = vv; }
    __syncthreads();
    const int hq = kvh * 8 + w; const float sink = ((const GAS float*)sinks)[hq] * 1.4426950408889634f;
#pragma unroll 1
    for (int qb = 0; qb < 8; ++qb) {
        const size_t tok = (size_t)b * T + n * 128 + 16 * qb + i;
        bf16* qp = SQ + tok * 1024 + hq * 64;
        const bf16x8 yq0 = *(const GAS bf16x8*)(qp + 8 * g), yq1 = *(const GAS bf16x8*)(qp + 32 + 8 * g);
        f32x4 st[10]; float mx = sink;
        const int qi = 128 + 16 * qb + i;
#pragma unroll
        for (int jt = 0; jt < 10; ++jt) { const int J = qb + jt;
            f32x4 a = (f32x4){0.f, 0.f, 0.f, 0.f};
            a = MFMA16(frag_nat(Ks, RS_S, 16 * J, 0, lane), yq0, a); a = MFMA16(frag_nat(Ks, RS_S, 16 * J, 32, lane), yq1, a);
#pragma unroll
            for (int r = 0; r < 4; ++r) { const int kj = 16 * J + 4 * g + r, rel = qi - kj; const bool ok = rel >= 0 && rel < 128 && (n > 0 || kj >= 128);
                a[r] = ok ? a[r] * 1.4426950408889634f : -INFINITY; mx = fmaxf(mx, a[r]); }
            st[jt] = a; }
        mx = fmaxf(mx, __shfl_xor(mx, 16)); mx = fmaxf(mx, __shfl_xor(mx, 32));
        float sum = 0.f;
#pragma unroll
        for (int jt = 0; jt < 10; ++jt)
#pragma unroll
            for (int r = 0; r < 4; ++r) { const float p = __builtin_amdgcn_exp2f(st[jt][r] - mx); st[jt][r] = p; sum += p; }
        sum += __shfl_xor(sum, 16); sum += __shfl_xor(sum, 32);
        const float inv = 1.0f / (sum + __builtin_amdgcn_exp2f(sink - mx));
        f32x4 o[4];
#pragma unroll
        for (int dt = 0; dt < 4; ++dt) o[dt] = (f32x4){0.f, 0.f, 0.f, 0.f};
#pragma unroll
        for (int kp = 0; kp < 5; ++kp) { const f32x4 pa = st[2 * kp] * inv, pb = st[2 * kp + 1] * inv;
            const bf16x8 pfr = __builtin_bit_cast(bf16x8, (v4u){pkbf(pa[0], pa[1]), pkbf(pa[2], pa[3]), pkbf(pb[0], pb[1]), pkbf(pb[2], pb[3])});
            const int ka = 16 * (qb + 2 * kp) + 4 * g;
#pragma unroll
            for (int dt = 0; dt < 4; ++dt) { const bf16x8 x = frag_tr(Vs, RS_S, ka, ka + 16, 16 * dt, lane); o[dt] = MFMA16(x, pfr, o[dt]); } }
#pragma unroll
        for (int dt = 0; dt < 4; ++dt) *(GAS v2u*)(qp + 16 * dt + 4 * g) = (v2u){pkbf(o[dt][0], o[dt][1]), pkbf(o[dt][2], o[dt][3])};
    }
    __syncthreads();
}
#ifndef DBG_P11_A
#define DBG_P11_A WS_XN
#endif
#ifndef PH_MASK
#define PH_MASK 0xFFFF
#endif
#define PH_ON(s) (((PH_MASK) >> (s)) & 1)
struct Args { const void* in[18]; float* out; unsigned char* ws; int ph_lo, ph_hi; };
constexpr int PH_PER_LAYER = 15, N_PHASES = DEPTH * PH_PER_LAYER + 1;
#define PH_BEGIN(k) if (PH_ON((k) % 15 + ((k) == 30 ? 15 : 0)) && lo <= (k) && (k) < hi) { \
        { int t_ = threadIdx.x; asm volatile("" : "+v"(t_)); F.tid = t_; F.lane = t_ & 63; F.wave = __builtin_amdgcn_readfirstlane(t_ >> 6); } \
        unsigned char* ws = ws_; asm volatile("" : "+s"(ws));
#define PH_END(k) if ((k) + 1 < hi) xcd_barrier(bar); }
#define GEMM_PHASE(EPI, Aptr, Wptr, Ncols, Kdim, ...) do { pg8::Gemm g{(const bf16*)(Aptr), (const bf16*)(Wptr), M, (Ncols), (Kdim)}; pg8::StaticOrder S; S.init(M, (Ncols), F.G, (int)blockIdx.x); \
        EPI E{__VA_ARGS__}; pg8::gemm_phase<EPI, pg8::StaticOrder, true, true>(F.lds, g, S, E); } while (0)
template <int L> __device__ __forceinline__ void layer_phases(Frame& F, const Args& args, unsigned char* ws_, const XcdBarrier& bar, const int lo, const int hi) {
    constexpr int P0 = L * PH_PER_LAYER;
    constexpr bool wrote_before = (L > 0) && (EN_FFN1 || EN_MIX || EN_FFN2);
    const float* x_in = (const float*)args.in[0]; float* xres = args.out;
#define X0 (wrote_before ? (const float*)xres : x_in)
#define X1 ((wrote_before || EN_FFN1) ? (const float*)xres : x_in)
#define X2 ((wrote_before || EN_FFN1 || EN_MIX) ? (const float*)xres : x_in)
#define MODP(i) ((const float*)(ws + WS_MOD) + (size_t)L * 2 * NMOD + (i) * D)
    PH_BEGIN(P0 + 0)
        LayerW W; W.up1 = (const float*)args.in[9] + (size_t)L * D * NUP; W.dn1 = (const float*)args.in[10] + (size_t)L * FF * D; W.up2 = (const float*)args.in[11] + (size_t)L * D * NUP;
        W.dn2 = (const float*)args.in[12] + (size_t)L * FF * D; W.win = (const float*)args.in[13] + (size_t)L * D * NIN; W.wbr = (const float*)args.in[15] + (size_t)L * D * D;
        W.wbs = (const float*)args.in[16] + (size_t)L * D * D; W.wout = (const float*)args.in[17] + (size_t)L * D * D;
        if (L == 0) mod_rope_phase(F, (const float*)args.in[1], (const float*)args.in[7], (const float*)args.in[8], (const int*)args.in[2], ws);
        conv_phase(F, W, ws);
    PH_END(P0 + 0)
    PH_BEGIN(P0 + 1) if (EN_FFN1) norm_phase(F, X0, (const float*)args.in[3] + L * D, MODP(0), MODP(1), (bf16*)(ws + WS_XN)); PH_END(P0 + 1)
    PH_BEGIN(P0 + 2) if (EN_FFN1) GEMM_PHASE(pg8::EpiSwiGLU, ws + WS_XN, ws + WS_WUP1, NUP, D, (bf16*)(ws + WS_H), FF); PH_END(P0 + 2)
    PH_BEGIN(P0 + 3) if (EN_FFN1) GEMM_PHASE(pg8::EpiRes, ws + WS_H, ws + WS_WDN1, D, FF, X0, xres, MODP(2), NMOD, 0.5f); PH_END(P0 + 3)
    PH_BEGIN(P0 + 4) if (EN_MIX) norm_phase(F, X1, (const float*)args.in[4] + L * D, MODP(3), MODP(4), (bf16*)(ws + WS_XN)); PH_END(P0 + 4)
    PH_BEGIN(P0 + 5) if (EN_MIX) GEMM_PHASE(pg8::EpiProj, ws + WS_XN, ws + WS_WIN, NIN, D, (bf16*)(ws + WS_RQ), (bf16*)(ws + WS_RK), (bf16*)(ws + WS_RV), (bf16*)(ws + WS_RG), (bf16*)(ws + WS_SQ), (bf16*)(ws + WS_SK), (bf16*)(ws + WS_SV),
            (bf16*)(ws + WS_GR), (bf16*)(ws + WS_GS), (const float*)(ws + WS_COSR), (const float*)(ws + WS_SINR), (const float*)(ws + WS_COSS), (const float*)(ws + WS_SINS)); PH_END(P0 + 5)
    PH_BEGIN(P0 + 6) if (EN_MIX) {
        for (int u = F.vcu; u < 512; u += F.G) kv_unit(F, u, (const bf16*)(ws + WS_RK), (const bf16*)(ws + WS_RV), (bf16*)(ws + WS_KV));
        for (int u = F.vcu; u < 256; u += F.G) swa_unit(F, u, (bf16*)(ws + WS_SQ), (const bf16*)(ws + WS_SK), (const bf16*)(ws + WS_SV), (const float*)args.in[14] + L * 16); }
    PH_END(P0 + 6)
    PH_BEGIN(P0 + 7) if (EN_MIX) scan_phase(F, (bf16*)(ws + WS_KV)); PH_END(P0 + 7)
    PH_BEGIN(P0 + 8) if (EN_MIX) { for (int u = F.vcu; u < 512; u += F.G) ret_unit(F, u, (const bf16*)(ws + WS_RQ), (const bf16*)(ws + WS_RK), (bf16*)(ws + WS_RV), (const bf16*)(ws + WS_RG), (const bf16*)(ws + WS_KV)); } PH_END(P0 + 8)
    PH_BEGIN(P0 + 9) if (EN_MIX) GEMM_PHASE(pg8::EpiMerge<0>, ws + WS_RV, ws + WS_WBR, D, D, (const bf16*)(ws + WS_GR), (const bf16*)nullptr, (bf16*)(ws + WS_TMP)); PH_END(P0 + 9)
    PH_BEGIN(P0 + 10) if (EN_MIX) GEMM_PHASE(pg8::EpiMerge<1>, ws + WS_SQ, ws + WS_WBS, D, D, (const bf16*)(ws + WS_GS), (const bf16*)(ws + WS_TMP), (bf16*)(ws + WS_XN)); PH_END(P0 + 10)
    PH_BEGIN(P0 + 11) if (EN_MIX) GEMM_PHASE(pg8::EpiRes, ws + DBG_P11_A, ws + WS_WOUT, D, D, X1, xres, MODP(5), NMOD, 1.0f); PH_END(P0 + 11)
    PH_BEGIN(P0 + 12) if (EN_FFN2) norm_phase(F, X2, (const float*)args.in[5] + L * D, MODP(6), MODP(7), (bf16*)(ws + WS_XN)); PH_END(P0 + 12)
    PH_BEGIN(P0 + 13) if (EN_FFN2) GEMM_PHASE(pg8::EpiSwiGLU, ws + WS_XN, ws + WS_WUP2, NUP, D, (bf16*)(ws + WS_H), FF); PH_END(P0 + 13)
    PH_BEGIN(P0 + 14) if (EN_FFN2) GEMM_PHASE(pg8::EpiRes, ws + WS_H, ws + WS_WDN2, D, FF, X2, xres, MODP(8), NMOD, 0.5f); PH_END(P0 + 14)
#undef X0
#undef X1
#undef X2
#undef MODP
}
__global__ void __launch_bounds__(NTHREADS, 2) fwd_kernel(Args args) {
    extern __shared__ __attribute__((aligned(16))) unsigned char lds_raw[];
    Frame F;
    F.lds = (LAS unsigned char*)lds_raw;
    F.tid = threadIdx.x; F.lane = F.tid & 63; F.wave = __builtin_amdgcn_readfirstlane(F.tid >> 6);
    F.G = gridDim.x; { const int bx = blockIdx.x; F.vcu = (F.G % 8 == 0) ? (bx % 8) * (F.G / 8) + bx / 8 : bx; }
    unsigned char* ws_ = args.ws;
    volatile LAS unsigned* MISC = (volatile LAS unsigned*)(F.lds + MISC_OFF);
    if (F.tid < 32) MISC[F.tid] = 0u;
    __syncthreads();
    const int lo = args.ph_lo, hi = args.ph_hi;
    XcdBarrier bar; bar.bar = (unsigned*)(ws_ + WS_CTL) + CW_BAR; bar.x = 0; bar.st = MISC + 8;
    if (hi - lo > 1) bar = xcd_barrier_post((unsigned*)(ws_ + WS_CTL) + CW_BAR, MISC + 8);

    layer_phases<0>(F, args, ws_, bar, lo, hi);
    layer_phases<1>(F, args, ws_, bar, lo, hi);
    PH_BEGIN(30)
        if (EN_FFN1 || EN_MIX || EN_FFN2) final_norm_phase(F, args.out, (const float*)args.in[6]);
        else { const float* x_in = (const float*)args.in[0]; const int gw = F.vcu * NWAVES + F.wave, NGW = F.G * NWAVES;
            for (int m = gw; m < M; m += NGW) { const GAS f32x4* xr = (const GAS f32x4*)(x_in + (size_t)m * D) + F.lane; GAS f32x4* orow = (GAS f32x4*)(args.out + (size_t)m * D) + F.lane;
                f32x4 v[4]; float ss = 0.f;
                for (int j = 0; j < 4; ++j) { v[j] = xr[64 * j]; ss += (v[j].x * v[j].x + v[j].y * v[j].y) + (v[j].z * v[j].z + v[j].w * v[j].w); }
                const float rstd = 1.0f / sqrtf(wave_sum(ss) * (1.0f / D) + NORM_EPS);
                for (int j = 0; j < 4; ++j) orow[64 * j] = (v[j] * rstd) * ((const GAS f32x4*)args.in[6])[F.lane + 64 * j]; } }
    PH_END(30)
}

extern "C" void kernel_launch(void* const* d_in, const int* in_sizes, int n_in, void* d_out, int out_size, void* d_ws, size_t ws_size, hipStream_t stream) {
    static int grid = 0;
    if (grid == 0) {
        if (n_in != 18 || in_sizes[0] != M * D || out_size != M * D || ws_size < WS_END) { fprintf(stderr, "kernel_launch: unexpected problem (n_in %d, in0 %d, out %d, ws %zu < %zu); nothing launched\n", n_in, n_in > 0 ? in_sizes[0] : -1, out_size, ws_size, (size_t)WS_END); grid = -1; return; }
        int dev = 0, cus = 0, per_cu = 0;
        if (hipGetDevice(&dev) != hipSuccess || hipDeviceGetAttribute(&cus, hipDeviceAttributeMultiprocessorCount, dev) != hipSuccess) { grid = -1; return; }
        if (hipFuncSetAttribute((const void*)fwd_kernel, hipFuncAttributeMaxDynamicSharedMemorySize, LDS_BYTES) != hipSuccess) { fprintf(stderr, "kernel_launch: hipFuncSetAttribute failed\n"); grid = -1; return; }
        if (hipOccupancyMaxActiveBlocksPerMultiprocessor(&per_cu, (const void*)fwd_kernel, NTHREADS, LDS_BYTES) != hipSuccess || per_cu < 1) fprintf(stderr, "kernel_launch: occupancy query says %d\n", per_cu);
        (void)hipGetLastError();
        grid = cus;
    }
    if (grid < 0) return;
#ifdef DBG_MEMSET_ALL
    (void)hipMemsetAsync((char*)d_ws, 0x11, WS_END, stream); (void)hipMemsetAsync(d_out, 0x11, (size_t)M * D * 4, stream);
#endif
    if (hipMemsetAsync((char*)d_ws + WS_CTL, 0, CTL_ZERO_BYTES, stream) != hipSuccess) { fprintf(stderr, "kernel_launch: memset failed\n"); return; }
    Args a{};
    for (int i = 0; i < 18; ++i) a.in[i] = d_in[i];
    a.out = (float*)d_out; a.ws = (unsigned char*)d_ws;
#if MK_ONE_LAUNCH
    a.ph_lo = 0; a.ph_hi = N_PHASES;
    hipLaunchKernelGGL(fwd_kernel, dim3(grid), dim3(NTHREADS), LDS_BYTES, stream, a);
#else
    for (int ph = 0; ph < N_PHASES; ++ph) { a.ph_lo = ph; a.ph_hi = ph + 1; hipLaunchKernelGGL(fwd_kernel, dim3(grid), dim3(NTHREADS), LDS_BYTES, stream, a); }
#endif
}
```

```cpp
#include <hip/hip_runtime.h>
#include <cstdio>
#include <cstdint>
#define WT_C true
namespace pg8 {
#define PG8_LAS __attribute__((address_space(3)))
typedef unsigned short bf16_t;
typedef short bf16x8 __attribute__((ext_vector_type(8)));
typedef float f32x4 __attribute__((ext_vector_type(4)));
typedef unsigned u32x4 __attribute__((ext_vector_type(4)));
constexpr size_t PSTR = 786432;
__host__ __device__ __forceinline__ size_t prow(size_t row) { return (row >> 8) * PSTR + (row & 255) * 1024; }
constexpr int BM = 256, BK = 64, HALF = 128, HTB = HALF * BK * 2  , STAGE_BYTES = 8 * HTB, NXCD = 8, WGM = 8;

__host__ __device__ __forceinline__ int lds_byte(int r, int c) { const int st = (r >> 4) * 2 + (c >> 5), rr = r & 15, cc = c & 31, ob = rr * 64 + cc * 2; return st * 1024 + (ob ^ (((ob >> 9) & 1) << 5)); }
__host__ __device__ __forceinline__ void stage_rc(int b, int& R, int& C) { const int st = b / 1024, sb = b % 1024, swz = sb ^ (((sb >> 9) & 1) << 5); R = (st >> 1) * 16 + swz / 64; C = (st & 1) * 32 + (swz % 64) / 2; }
__host__ __device__ __forceinline__ int perm32(int rho) { const int n = rho >> 4, i = rho & 15; return 8 * (i >> 2) + 4 * n + (i & 3); }

struct Unit { int pm, pn; };
struct Gemm { const bf16_t* A; const bf16_t* Bt; int M, N, K; int lda = 0; const bf16_t* A2 = nullptr; const void* pf = nullptr; int pf_pitch = 0; size_t a_tile = 0;   };

struct StaticOrder {
    int nM, nN, nwg, G, c;
    __host__ __device__ void init(int M, int N, int G_, int c_) { nM = M / BM; nN = N / BM; nwg = nM * nN; G = G_; c = c_; }
    __host__ __device__ bool next(int i, Unit& u) const {
        const long L = (long)i * G + c; if (L >= nwg) return false;
        int wgid = (int)L; { const int q = nwg / NXCD, r = nwg % NXCD, xcd = wgid % NXCD, off = wgid / NXCD; wgid = (xcd < r ? xcd * (q + 1) : r * (q + 1) + (xcd - r) * q) + off; }
        const int nig = WGM * nN, gid = wgid / nig, fm = gid * WGM, gsz = (nM - fm) < WGM ? (nM - fm) : WGM;
        u.pm = fm + ((wgid % nig) % gsz); u.pn = (wgid % nig) / gsz; return true;
    }
    __device__ __forceinline__ void a_ready(const Unit&) const {}
    __device__ __forceinline__ void done(const Unit&) const {}
};

template <class Epi, class Sched, bool ALIGN_EPI = false, bool SP2 = false>
__device__ __forceinline__ void gemm_phase(PG8_LAS unsigned char* lds, const Gemm g, const Sched& S, const Epi& E, const int w0) {
    int tid_; asm volatile("v_mbcnt_lo_u32_b32 %0, -1, 0\n\tv_mbcnt_hi_u32_b32 %0, -1, %0" : "=v"(tid_)); tid_ += w0 * 64;
    const int tid = tid_, wid = __builtin_amdgcn_readfirstlane(tid >> 6), lane = tid & 63, wr = wid >> 2, wc = wid & 3, fr = lane & 15, fq = lane >> 4;
    const int K = g.K, nt = K / BK;
    unsigned voffA[2], voffB[2];
#pragma unroll
    for (int i = 0; i < 2; ++i) { int R, C; stage_rc(tid * 16 + i * 8192, R, C); const int Rb = Epi::PERM ? ((R & ~31) + perm32(R & 31)) : R;
        voffA[i] = (unsigned)(R * (g.lda ? g.lda : K) + C) * 2u; voffB[i] = (unsigned)(Rb * K + C) * 2u; }
    asm volatile("" : "+v"(voffA[0]), "+v"(voffA[1]), "+v"(voffB[0]), "+v"(voffB[1]));
    const size_t kstep = (size_t)(BK * 2);
    const size_t hstep = (size_t)HALF * K * 2;
    const size_t tstep = 2 * hstep;
    const int lda = g.lda ? g.lda : K; const size_t hstepA = (size_t)HALF * lda * 2, tstepA = g.a_tile ? g.a_tile : 2 * hstepA; const int ntA = nt / 2;
    const unsigned ldsw = (unsigned)wid * 1024u;
    const int aoff = lds_byte(wr * 64 + fr, fq * 8), boff = lds_byte(wc * 32 + fr, fq * 8);
#define PG8_SA(b, h) (((b) * 2 + (h)) * HTB)
#define PG8_SB(b, h) ((4 + (b) * 2 + (h)) * HTB)
#define PG8_STAGE(bufoff, gbase, voff) do { _Pragma("unroll") for (int _i = 0; _i < 2; ++_i) \
        __builtin_amdgcn_global_load_lds((const unsigned*)((const char*)(gbase) + (voff)[_i]), (PG8_LAS unsigned*)(lds + (bufoff) + ldsw + _i * 8192), 16, 0, 0); } while (0)
#define PG8_STAGE2(bufoff, gbase, o0, o1) do { __builtin_amdgcn_global_load_lds((const unsigned*)((const char*)(gbase) + (o0)), (PG8_LAS unsigned*)(lds + (bufoff) + ldsw), 16, 0, 0); \
        __builtin_amdgcn_global_load_lds((const unsigned*)((const char*)(gbase) + (o1)), (PG8_LAS unsigned*)(lds + (bufoff) + ldsw + 8192), 16, 0, 0); } while (0)
#define PG8_LDA(dst, b, h) do { _Pragma("unroll") for (int m = 0; m < 4; ++m) _Pragma("unroll") for (int k = 0; k < 2; ++k) dst[m][k] = *(const PG8_LAS bf16x8*)(lds + PG8_SA(b, h) + aoff + m * 2048 + k * 1024); } while (0)
#define PG8_LDB(dst, b, h) do { _Pragma("unroll") for (int n = 0; n < 2; ++n) _Pragma("unroll") for (int k = 0; k < 2; ++k) dst[n][k] = *(const PG8_LAS bf16x8*)(lds + PG8_SB(b, h) + boff + n * 2048 + k * 1024); } while (0)
#define PG8_MMA(ai, bj, At, Bt) do { __builtin_amdgcn_s_setprio(1); _Pragma("unroll") for (int m = 0; m < 4; ++m) _Pragma("unroll") for (int n = 0; n < 2; ++n) _Pragma("unroll") for (int k = 0; k < 2; ++k) \
        acc[ai][bj][m][n] = __builtin_amdgcn_mfma_f32_16x16x32_bf16(Bt[n][k], At[m][k], acc[ai][bj][m][n], 0, 0, 0); __builtin_amdgcn_s_setprio(0); } while (0)
#define PG8_WAIT_V_(n) asm volatile("s_waitcnt vmcnt(" #n ")" ::: "memory")
#define PG8_WAIT_V(n) PG8_WAIT_V_(n)
#define PG8_WAIT_L(n) asm volatile("s_waitcnt lgkmcnt(" #n ")" ::: "memory")
#define PG8_BAR __builtin_amdgcn_s_barrier()
#define PG8_WAIT_VD(n) do { if (dfl_) PG8_WAIT_V(n); else PG8_WAIT_V(8); } while (0)
#define PG8_WAIT_VE() do { if (dfl_) { if constexpr (Epi::ND == 4) PG8_WAIT_V(10); else PG8_WAIT_V(9); } else PG8_WAIT_V(8); } while (0)
#define PG8_DST(j) do { const u32x4 v_ = *(const PG8_LAS u32x4*)(dlds + (j) * 8192); E.dstore((j), v_, prv, wr, wc, fr, fq); } while (0)
#define PG8_ITER_SP2(WVA, WVB, LASTEXPR, DSA, DSB) do { \
            const bool last = (LASTEXPR); \
            if constexpr (Epi::HAS_MID) { if (t == ntA) E.mid(acc, cur, wr, wc, fr, fq); } \
            const char* a1 = PG8_AP(t + 1); \
            const char* a2 = last ? nA : PG8_AP(t + 2); const char* b2 = last ? nB : cB + (size_t)(t + 2) * kstep; \
            const char* a3 = a2 + kstep; const char* b3 = b2 + kstep; \
            if (last && has_next) S.a_ready(nxt); \
            bool pf_ = false; if constexpr (Epi::PF) pf_ = last && !has_next && g.pf != nullptr; \
            const char* pfb_ = pf_ ? (const char*)g.pf + ((size_t)cur.pm * 256) * g.pf_pitch + (size_t)cur.pn * 512 : cB; const size_t pfs_ = (size_t)32 * g.pf_pitch; \
            const unsigned pfo0_ = (unsigned)((tid >> 5) * g.pf_pitch + (tid & 31) * 16), pfo1_ = pfo0_ + 16u * (unsigned)g.pf_pitch; \
            const unsigned vB0_ = pf_ ? pfo0_ : voffB[0], vB1_ = pf_ ? pfo1_ : voffB[1], vA0_ = pf_ ? pfo0_ : voffA[0], vA1_ = pf_ ? pfo1_ : voffA[1]; \
            DSA; \
            PG8_LDB(B0, 0, 0); PG8_LDB(B1, 0, 1); PG8_SCHED; PG8_LDA(At, 0, 0); PG8_STAGE(PG8_SA(1, 1), a1 + hstepA, voffA); \
            PG8_WAIT_VD(10); PG8_WAIT_L(0); PG8_BAR; PG8_MMA(0, 0, At, B0); PG8_MMA(0, 1, At, B1); PG8_BAR; PG8_SCHED; \
            PG8_LDA(At, 0, 1); PG8_STAGE2(PG8_SB(0, 0), pf_ ? pfb_ : b2, vB0_, vB1_); PG8_STAGE2(PG8_SB(0, 1), pf_ ? pfb_ + pfs_ : b2 + hstep, vB0_, vB1_); PG8_STAGE2(PG8_SA(0, 0), pf_ ? pfb_ + 2 * pfs_ : a2, vA0_, vA1_); \
            PG8_WAIT_VD(10); PG8_WAIT_L(0); PG8_BAR; PG8_MMA(1, 0, At, B0); PG8_MMA(1, 1, At, B1); PG8_BAR; PG8_SCHED; \
            DSB; \
            PG8_LDB(B0, 1, 0); PG8_LDB(B1, 1, 1); PG8_SCHED; PG8_LDA(At, 1, 0); PG8_STAGE2(PG8_SA(0, 1), pf_ ? pfb_ + 3 * pfs_ : a2 + hstepA, vA0_, vA1_); \
            PG8_WAIT_VE(); PG8_WAIT_L(0); PG8_BAR; PG8_MMA(0, 0, At, B0); PG8_MMA(0, 1, At, B1); PG8_BAR; PG8_SCHED; \
            PG8_LDA(At, 1, 1); PG8_STAGE2(PG8_SB(1, 0), pf_ ? pfb_ + 4 * pfs_ : b3, vB0_, vB1_); PG8_STAGE2(PG8_SB(1, 1), pf_ ? pfb_ + 5 * pfs_ : b3 + hstep, vB0_, vB1_); PG8_STAGE2(PG8_SA(1, 0), pf_ ? pfb_ + 6 * pfs_ : a3, vA0_, vA1_); \
            PG8_WAIT_VE(); PG8_WAIT_L(0); PG8_BAR; PG8_MMA(1, 0, At, B0); PG8_MMA(1, 1, At, B1); PG8_BAR; PG8_SCHED; \
        } while (0)
#define PG8_SCHED __builtin_amdgcn_sched_barrier(0)
    static_assert(SP2 || !Epi::HAS_MID, "the two-half A operand is wired into the SP2 loop only");
    Unit cur, nxt; int ui = 0;
    if (!S.next(0, cur)) return;
    f32x4 acc[2][2][4][2];
#pragma unroll
    for (int a = 0; a < 2; ++a)
#pragma unroll
        for (int b = 0; b < 2; ++b)
#pragma unroll
            for (int m = 0; m < 4; ++m)
#pragma unroll
                for (int n = 0; n < 2; ++n) acc[a][b][m][n] = (f32x4){0.f, 0.f, 0.f, 0.f};
    bf16x8 At[4][2], B0[2][2], B1[2][2];
    Unit prv = {0, 0}; bool pend = false; (void)prv; (void)pend;
    static_assert(Epi::ND == 0 || Epi::ND == 3 || Epi::ND == 4 || true, "deferred stores: one K-loop iteration, groups of 2 + 1 or 2 + 2");
    PG8_LAS unsigned char* const dlds = lds + STAGE_BYTES + tid * 16; (void)dlds;
    const char* cA = (const char*)g.A + (size_t)cur.pm * tstepA; const char* cB = (const char*)g.Bt + (size_t)cur.pn * tstep;
    const char* cA2 = cA; if constexpr (Epi::HAS_MID) cA2 = (const char*)g.A2 + (size_t)cur.pm * tstepA - (size_t)ntA * kstep;
#define PG8_AP(tile) (Epi::HAS_MID && (tile) >= ntA ? cA2 + (size_t)(tile) * kstep : cA + (size_t)(tile) * kstep)
    S.a_ready(cur);
    if constexpr (SP2) {
        PG8_STAGE(PG8_SB(0, 0), cB, voffB); PG8_STAGE(PG8_SB(0, 1), cB + hstep, voffB); PG8_STAGE(PG8_SA(0, 0), cA, voffA); PG8_STAGE(PG8_SA(0, 1), cA + hstepA, voffA);
        if (wr == 1) PG8_BAR;
        PG8_WAIT_V(2); PG8_BAR;
        PG8_STAGE(PG8_SB(1, 0), cB + kstep, voffB); PG8_STAGE(PG8_SA(1, 0), cA + kstep, voffA); PG8_STAGE(PG8_SB(1, 1), cB + hstep + kstep, voffB);
        PG8_WAIT_V(6); PG8_BAR;
    } else {
        PG8_STAGE(PG8_SB(0, 0), cB, voffB); PG8_STAGE(PG8_SA(0, 0), cA, voffA); PG8_STAGE(PG8_SB(0, 1), cB + hstep, voffB); PG8_STAGE(PG8_SA(0, 1), cA + hstep, voffA);
        if (wr == 1) PG8_BAR;
        PG8_WAIT_V(4); PG8_BAR;
        PG8_STAGE(PG8_SB(1, 0), cB + kstep, voffB); PG8_STAGE(PG8_SA(1, 0), cA + kstep, voffA); PG8_STAGE(PG8_SB(1, 1), cB + hstep + kstep, voffB);
        PG8_WAIT_V(6); PG8_BAR;
    }
    for (;;) {
        const bool has_next = S.next(ui + 1, nxt);
        const char* nA = has_next ? (const char*)g.A + (size_t)nxt.pm * tstepA : cA; const char* nB = has_next ? (const char*)g.Bt + (size_t)nxt.pn * tstep : cB;
        int t = 0;
        if constexpr (SP2) {
            for (; t < nt; t += 2) {
                bool dfl_ = false; if constexpr (Epi::ND > 0) dfl_ = pend && t == 0;
                PG8_ITER_SP2(A, B, t == nt - 2, do { if constexpr (Epi::ND > 0) { if (dfl_) { PG8_DST(0); PG8_DST(1); } } } while (0), do { if constexpr (Epi::ND > 0) { if (dfl_) { PG8_DST(2); if constexpr (Epi::ND == 4) PG8_DST(3); } } } while (0));
            }
        } else {
        for (; t < nt; t += 2) {
            const bool last = (t == nt - 2);
            if constexpr (Epi::HAS_MID) { if (t == ntA) E.mid(acc, cur, wr, wc, fr, fq); }
            const char* a1 = PG8_AP(t + 1);
            const char* a2 = last ? nA : PG8_AP(t + 2); const char* b2 = last ? nB : cB + (size_t)(t + 2) * kstep;
            const char* a3 = a2 + kstep; const char* b3 = b2 + kstep;
            if (last && has_next) S.a_ready(nxt);
            bool pf_ = false; if constexpr (Epi::PF) pf_ = last && !has_next && g.pf != nullptr;
            const char* pfb_ = pf_ ? (const char*)g.pf + ((size_t)cur.pm * 256) * g.pf_pitch + (size_t)cur.pn * 512 : cB; const size_t pfs_ = (size_t)32 * g.pf_pitch;
            const unsigned pfo0_ = (unsigned)((tid >> 5) * g.pf_pitch + (tid & 31) * 16), pfo1_ = pfo0_ + 16u * (unsigned)g.pf_pitch;
            const unsigned vB0_ = pf_ ? pfo0_ : voffB[0], vB1_ = pf_ ? pfo1_ : voffB[1], vA0_ = pf_ ? pfo0_ : voffA[0], vA1_ = pf_ ? pfo1_ : voffA[1];
            PG8_LDB(B0, 0, 0); PG8_SCHED; PG8_LDA(At, 0, 0); PG8_STAGE(PG8_SA(1, 1), a1 + hstep, voffA);
            PG8_WAIT_L(8); PG8_BAR; PG8_WAIT_L(0); PG8_MMA(0, 0, At, B0); PG8_BAR; PG8_SCHED;
            PG8_LDB(B1, 0, 1); PG8_STAGE(PG8_SB(0, 0), b2, voffB);
            PG8_BAR; PG8_WAIT_L(0); PG8_MMA(0, 1, At, B1); PG8_BAR;
            PG8_LDA(At, 0, 1); PG8_STAGE(PG8_SA(0, 0), a2, voffA);
            PG8_BAR; PG8_WAIT_L(0); PG8_MMA(1, 0, At, B0); PG8_BAR; PG8_SCHED;
            PG8_STAGE(PG8_SB(0, 1), b2 + hstep, voffB);
            PG8_WAIT_V(6); PG8_BAR; PG8_MMA(1, 1, At, B1); PG8_BAR;
            PG8_LDB(B0, 1, 0); PG8_SCHED; PG8_LDA(At, 1, 0); PG8_STAGE(PG8_SA(0, 1), a2 + hstep, voffA);
            PG8_WAIT_L(8); PG8_BAR; PG8_WAIT_L(0); PG8_MMA(0, 0, At, B0); PG8_BAR; PG8_SCHED;
            PG8_LDB(B1, 1, 1); PG8_STAGE(PG8_SB(1, 0), b3, voffB);
            PG8_BAR; PG8_WAIT_L(0); PG8_MMA(0, 1, At, B1); PG8_BAR;
            PG8_LDA(At, 1, 1); PG8_STAGE(PG8_SA(1, 0), a3, voffA);
            PG8_BAR; PG8_WAIT_L(0); PG8_MMA(1, 0, At, B0); PG8_BAR; PG8_SCHED;
            PG8_STAGE(PG8_SB(1, 1), b3 + hstep, voffB);
            PG8_WAIT_V(6); PG8_BAR; PG8_MMA(1, 1, At, B1); PG8_BAR;
            }
        }
        if constexpr (ALIGN_EPI) { if (wr == 0) PG8_BAR; }
        int fr_e, fq_e; { int l_; asm volatile("v_mbcnt_lo_u32_b32 %0, -1, 0\n\tv_mbcnt_hi_u32_b32 %0, -1, %0" : "=v"(l_)); fr_e = l_ & 15; fq_e = l_ >> 4; }
        if constexpr (Epi::ND > 0) { static_assert(SP2 && !Epi::AFTER_DRAIN, "deferred stores are wired into the SP2 loop only");
            if (has_next) { E.template run<true>(acc, cur, wr, wc, fr_e, fq_e, dlds); prv = cur; pend = true; } else { E.template run<false>(acc, cur, wr, wc, fr_e, fq_e, dlds); pend = false; }
            S.done(cur); }
        else if constexpr (!Epi::AFTER_DRAIN) { E(acc, cur, wr, wc, fr_e, fq_e); S.done(cur); }
        if (!has_next) break;
#pragma unroll
        for (int a = 0; a < 2; ++a)
#pragma unroll
            for (int b = 0; b < 2; ++b)
#pragma unroll
                for (int m = 0; m < 4; ++m)
#pragma unroll
                    for (int n = 0; n < 2; ++n) acc[a][b][m][n] = (f32x4){0.f, 0.f, 0.f, 0.f};
        cur = nxt; cA = nA; cB = nB; ++ui; if constexpr (Epi::HAS_MID) cA2 = (const char*)g.A2 + (size_t)cur.pm * tstepA - (size_t)ntA * kstep;
        if constexpr (ALIGN_EPI) { if (wr == 1) PG8_BAR; }
    }
    PG8_WAIT_V(0);
    if constexpr (!ALIGN_EPI) { if (wr == 0) PG8_BAR; }
    PG8_BAR;
    if constexpr (Epi::AFTER_DRAIN) { E.fused(acc, cur, wr, wc, fr, fq, lds, wid, lane); S.done(cur); }
#undef PG8_AP
#undef PG8_STAGE2
#undef PG8_SA
#undef PG8_SB
#undef PG8_STAGE
#undef PG8_LDA
#undef PG8_LDB
#undef PG8_MMA
#undef PG8_WAIT_V
#undef PG8_WAIT_V_
#undef PG8_ITER_SP2
#undef PG8_DST
#undef PG8_WAIT_VD
#undef PG8_WAIT_VE
#undef PG8_WAIT_L
#undef PG8_BAR
#undef PG8_SCHED
}
}
namespace pg8 {
#define PG8_GAS __attribute__((address_space(1)))
typedef float f32x2_cv __attribute__((ext_vector_type(2))); typedef __bf16 bf16x2_cv __attribute__((ext_vector_type(2)));
__device__ __forceinline__ unsigned cvt_pk_bf16(float lo, float hi) { const f32x2_cv v = {lo, hi}; const bf16x2_cv b = __builtin_convertvector(v, bf16x2_cv); return __builtin_bit_cast(unsigned, b); }
__device__ __forceinline__ float fsigmoid(float x) { return __builtin_amdgcn_rcpf(1.0f + __builtin_amdgcn_exp2f(-1.4426950408889634f * x)); }
__device__ __forceinline__ float fsilu(float x) { return x * fsigmoid(x); }
__device__ __forceinline__ u32x4 pack8(const f32x4 a, const f32x4 b) { u32x4 w; w.x = cvt_pk_bf16(a[0], a[1]); w.y = cvt_pk_bf16(a[2], a[3]); w.z = cvt_pk_bf16(b[0], b[1]); w.w = cvt_pk_bf16(b[2], b[3]); return w; }
__device__ __forceinline__ void unpack8(const u32x4 w, f32x4& a, f32x4& b) {
    a[0] = __uint_as_float(w.x << 16); a[1] = __uint_as_float(w.x & 0xffff0000u); a[2] = __uint_as_float(w.y << 16); a[3] = __uint_as_float(w.y & 0xffff0000u);
    b[0] = __uint_as_float(w.z << 16); b[1] = __uint_as_float(w.z & 0xffff0000u); b[2] = __uint_as_float(w.w << 16); b[3] = __uint_as_float(w.w & 0xffff0000u); }

__device__ __forceinline__ void fold_apply(f32x4 (&acc)[2][2][4][2], const Unit& u, int wr, int wc, int fr, int fq, const float* SS, const float* T) {
    const int row0 = u.pm * BM + wr * 64 + fr, c0 = u.pn * BM + wc * 32 + 8 * fq;
    const float* Tb = T + (u.pm >= 32 ? 6400 : 0);
    f32x4 tv[2][2];
#pragma unroll
    for (int bj = 0; bj < 2; ++bj)
#pragma unroll
        for (int n = 0; n < 2; ++n) tv[bj][n] = *(const PG8_GAS f32x4*)(Tb + c0 + bj * HALF + 4 * n);
#pragma unroll
    for (int ai = 0; ai < 2; ++ai)
#pragma unroll
        for (int m = 0; m < 4; ++m) { const float ss = *(const PG8_GAS float*)(SS + row0 + ai * HALF + m * 16); const float r = __builtin_amdgcn_rsqf(ss * (1.0f / 1024.0f) + 1e-6f);
#pragma unroll
            for (int bj = 0; bj < 2; ++bj)
#pragma unroll
                for (int n = 0; n < 2; ++n) acc[ai][bj][m][n] = acc[ai][bj][m][n] * r + tv[bj][n]; }
}
#ifndef DEFER_UP
#define DEFER_UP 3
#endif
struct EpiSwiGLU {
    static constexpr bool PERM = true, AFTER_DRAIN = false, HAS_MID = false, PF = false, SLAB = false;
    static constexpr int ND = DEFER_UP;
    bf16_t* H; int ldh; const float* SS; const float* T;
    __device__ __forceinline__ void sstore(int j8, const u32x4& v, const Unit& u, int wr, int wc, int fr, int fq) const {
        const int lrow = wr * 64 + fr + (j8 >> 2) * HALF + (j8 & 3) * 16, col0 = u.pn * HALF + wc * 32 + 8 * fq;
        *(PG8_GAS u32x4*)(H + (size_t)u.pm * PSTR + (size_t)lrow * ldh + col0) = v;
    }
    __device__ __forceinline__ void dstore(int j, const u32x4& v, const Unit& u, int wr, int wc, int fr, int fq) const { sstore(j + (8 - ND), v, u, wr, wc, fr, fq); }
    template <bool DEFER> __device__ __forceinline__ void run(f32x4 (&acc)[2][2][4][2], const Unit& u, int wr, int wc, int fr, int fq, PG8_LAS unsigned char* dl) const {
        if (SS) fold_apply(acc, u, wr, wc, fr, fq, SS, T);
#pragma unroll
        for (int ai = 0; ai < 2; ++ai)
#pragma unroll
            for (int m = 0; m < 4; ++m) { f32x4 v0, v1;
#pragma unroll
                for (int e = 0; e < 4; ++e) { v0[e] = fsilu(acc[ai][0][m][0][e]) * acc[ai][1][m][0][e]; v1[e] = fsilu(acc[ai][0][m][1][e]) * acc[ai][1][m][1][e]; }
                const int j = ai * 4 + m - (8 - ND);
                if (DEFER && j >= 0) *(PG8_LAS u32x4*)(dl + j * 8192) = pack8(v0, v1); else sstore(ai * 4 + m, pack8(v0, v1), u, wr, wc, fr, fq); }
    }
    __device__ __forceinline__ void operator()(f32x4 (&acc)[2][2][4][2], const Unit& u, int wr, int wc, int fr, int fq) const { run<false>(acc, u, wr, wc, fr, fq, nullptr); }
};
typedef _Float16 f16x8_t __attribute__((ext_vector_type(8)));
typedef float f32x8_t __attribute__((ext_vector_type(8)));
constexpr int XP = 2048;
template <bool NEXT, bool INF32, bool SLAB_ = false> struct EpiRes {
    static constexpr bool PERM = true, AFTER_DRAIN = false, HAS_MID = false, PF = !INF32, SLAB = SLAB_; static constexpr int ND = 0;
    const void* xin; _Float16* xout; const float* gate; int gstride; float coef;
    bf16_t* XB; const float* gainN; const float* scN; float* SSo;
    __device__ __forceinline__ void operator()(f32x4 (&acc)[2][2][4][2], const Unit& u, int wr, int wc, int fr, int fq) const {
        const int row0 = u.pm * BM + wr * 64 + fr, col0 = u.pn * BM + wc * 32 + 8 * fq, bo = (u.pm >= 32 ? gstride : 0);
        const float* g = gate + bo;
        f32x4 gv[2][2], wv[2][2];
#pragma unroll
        for (int bj = 0; bj < 2; ++bj)
#pragma unroll
            for (int n = 0; n < 2; ++n) { gv[bj][n] = *(const PG8_GAS f32x4*)(g + col0 + bj * HALF + n * 4) * coef;
                if (NEXT) wv[bj][n] = *(const PG8_GAS f32x4*)(gainN + col0 + bj * HALF + n * 4) * (*(const PG8_GAS f32x4*)(scN + bo + col0 + bj * HALF + n * 4) + 1.0f); }
#pragma unroll
        for (int ai = 0; ai < 2; ++ai)
#pragma unroll
            for (int m = 0; m < 4; ++m) { const int row = row0 + ai * HALF + m * 16; float ssum = 0.f;
#pragma unroll
                for (int bj = 0; bj < 2; ++bj) { f32x4 xn[2]; const int col = col0 + bj * HALF;
                    if (INF32) { const float* xf = (const float*)xin + (size_t)row * 1024 + col; xn[0] = __builtin_nontemporal_load((const PG8_GAS f32x4*)xf); xn[1] = __builtin_nontemporal_load((const PG8_GAS f32x4*)(xf + 4)); }
                    else { const f16x8_t hv = *(const PG8_GAS f16x8_t*)((const _Float16*)xin + (size_t)row * XP + col); const f32x8_t fv = __builtin_convertvector(hv, f32x8_t);
                        xn[0] = (f32x4){fv[0], fv[1], fv[2], fv[3]}; xn[1] = (f32x4){fv[4], fv[5], fv[6], fv[7]}; }
                    xn[0] += gv[bj][0] * acc[ai][bj][m][0]; xn[1] += gv[bj][1] * acc[ai][bj][m][1];
                    { const f32x8_t ov = {xn[0][0], xn[0][1], xn[0][2], xn[0][3], xn[1][0], xn[1][1], xn[1][2], xn[1][3]}; *(PG8_GAS f16x8_t*)(xout + (size_t)row * XP + col) = __builtin_convertvector(ov, f16x8_t); }
                    if (NEXT) { ssum += (xn[0][0] * xn[0][0] + xn[0][1] * xn[0][1]) + (xn[0][2] * xn[0][2] + xn[0][3] * xn[0][3]) + (xn[1][0] * xn[1][0] + xn[1][1] * xn[1][1]) + (xn[1][2] * xn[1][2] + xn[1][3] * xn[1][3]);
                        *(PG8_GAS u32x4*)(XB + (size_t)row * 1024 + col) = pack8(xn[0] * wv[bj][0], xn[1] * wv[bj][1]); } }
                if (NEXT) { { auto r16 = __builtin_amdgcn_permlane16_swap(__float_as_uint(ssum), __float_as_uint(ssum), false, false); ssum = __uint_as_float(r16[0]) + __uint_as_float(r16[1]); }
                    { auto r32 = __builtin_amdgcn_permlane32_swap(__float_as_uint(ssum), __float_as_uint(ssum), false, false); ssum = __uint_as_float(r32[0]) + __uint_as_float(r32[1]); }
                    if (fq == 0) (void)__hip_atomic_fetch_add((PG8_GAS float*)SSo + row, ssum, __ATOMIC_RELAXED, __HIP_MEMORY_SCOPE_AGENT); } }
    }
};
struct EpiMergeCat {
    static constexpr bool PERM = true, AFTER_DRAIN = false, HAS_MID = true, PF = true, SLAB = false; static constexpr int ND = 0;
    const bf16_t* GR; const bf16_t* GS; bf16_t* O;
    __device__ __forceinline__ void mid(f32x4 (&acc)[2][2][4][2], const Unit& u, int wr, int wc, int fr, int fq) const {
        int fr_ = fr; asm volatile("" : "+v"(fr_));
        const unsigned off0 = (unsigned)((u.pm * BM + wr * 64 + fr_) * 1024 + u.pn * BM + wc * 32 + 8 * fq) * 2u;
        const PG8_GAS unsigned char* gr = (const PG8_GAS unsigned char*)GR; const PG8_GAS unsigned char* gs = (const PG8_GAS unsigned char*)GS;
#pragma unroll
        for (int ai = 0; ai < 2; ++ai) {
            u32x4 rv[4][2], sv[4][2];
#pragma unroll
            for (int m = 0; m < 4; ++m)
#pragma unroll
                for (int bj = 0; bj < 2; ++bj) { const unsigned off = off0 + (unsigned)((ai * HALF + m * 16) * 2048 + bj * 256); rv[m][bj] = __builtin_nontemporal_load((const PG8_GAS u32x4*)(gr + off)); sv[m][bj] = *(const PG8_GAS u32x4*)(gs + off); }
#pragma unroll
            for (int m = 0; m < 4; ++m)
#pragma unroll
                for (int bj = 0; bj < 2; ++bj) { f32x4 r0, r1, s0, s1; unpack8(rv[m][bj], r0, r1); unpack8(sv[m][bj], s0, s1);
#pragma unroll
                    for (int e = 0; e < 4; ++e) { acc[ai][bj][m][0][e] *= r0[e] * __builtin_amdgcn_rcpf(fmaxf(s0[e], 1e-30f)); acc[ai][bj][m][1][e] *= r1[e] * __builtin_amdgcn_rcpf(fmaxf(s1[e], 1e-30f)); } }
            asm volatile("" ::: "memory"); }
    }
    __device__ __forceinline__ void operator()(f32x4 (&acc)[2][2][4][2], const Unit& u, int wr, int wc, int fr, int fq) const {
        const int row0 = u.pm * BM + wr * 64 + fr, col0 = u.pn * BM + wc * 32 + 8 * fq;
#pragma unroll
        for (int ai = 0; ai < 2; ++ai)
#pragma unroll
            for (int m = 0; m < 4; ++m) { const size_t off = (size_t)(row0 + ai * HALF + m * 16) * 1024 + col0;
#pragma unroll
                for (int bj = 0; bj < 2; ++bj) { f32x4 s0, s1; unpack8(__builtin_nontemporal_load((const PG8_GAS u32x4*)(GS + off + bj * HALF)), s0, s1);
                    *(PG8_GAS u32x4*)(O + off + bj * HALF) = pack8(s0 * acc[ai][bj][m][0], s1 * acc[ai][bj][m][1]); } }
    }
};
struct EpiProj {
    static constexpr bool PERM = true, AFTER_DRAIN = false, HAS_MID = false, PF = false, SLAB = false; static constexpr int ND = 0;
    bf16_t *RQ, *RK, *RV, *RG, *SQ, *SK, *SV, *GR, *GS; const float *cosr, *sinr, *coss, *sins; const float* SS; const float* T;
    __device__ __forceinline__ void operator()(f32x4 (&acc)[2][2][4][2], const Unit& u, int wr, int wc, int fr, int fq) const {
        if (SS) fold_apply(acc, u, wr, wc, fr, fq, SS, T);
        const int pn = u.pn, row0 = u.pm * BM + wr * 64 + fr, j0 = wc * 32 + 8 * fq;
        if (pn < 4) {
            const bool isq = pn < 2; const int head = 2 * (pn & 1) + (wc >> 1), i0 = j0 & 63;
            bf16_t* O = isq ? RQ : RK;
            const float lg = __log2f(1.0f - __builtin_amdgcn_exp2f(-5.0f - (float)head)) * (isq ? 1.0f : -1.0f);
            const float sc = isq ? 0.08838834764831845f : 1.0f;
#pragma unroll
            for (int ai = 0; ai < 2; ++ai)
#pragma unroll
                for (int m = 0; m < 4; ++m) { const int row = row0 + ai * HALF + m * 16; const float dec = __builtin_amdgcn_exp2f((float)(row & 127) * lg) * sc;
                    f32x4 o1[2], o2[2];
#pragma unroll
                    for (int n = 0; n < 2; ++n) { const f32x4 c = *(const PG8_GAS f32x4*)(cosr + (size_t)row * 64 + i0 + 4 * n), s = *(const PG8_GAS f32x4*)(sinr + (size_t)row * 64 + i0 + 4 * n);
                        const f32x4 x1 = acc[ai][0][m][n], x2 = acc[ai][1][m][n]; o1[n] = (x1 * c - x2 * s) * dec; o2[n] = (x2 * c + x1 * s) * dec; }
                    bf16_t* p = O + (size_t)row * 512 + head * 128 + i0; *(PG8_GAS u32x4*)p = pack8(o1[0], o1[1]); *(PG8_GAS u32x4*)(p + 64) = pack8(o2[0], o2[1]); if (m & 1) asm volatile("" ::: "memory"); }
        } else if (pn < 12) {
            const bool isg = pn >= 8; bf16_t* O = isg ? RG : RV; const int colt = ((pn - 4) & 3) * 256 + j0;
#pragma unroll
            for (int ai = 0; ai < 2; ++ai)
#pragma unroll
                for (int m = 0; m < 4; ++m) { const int row = row0 + ai * HALF + m * 16;
#pragma unroll
                    for (int bj = 0; bj < 2; ++bj) { f32x4 v0 = acc[ai][bj][m][0], v1 = acc[ai][bj][m][1];
                        if (isg) {
#pragma unroll
                            for (int e = 0; e < 4; ++e) { v0[e] = fsilu(v0[e]); v1[e] = fsilu(v1[e]); } }
                        *(PG8_GAS u32x4*)(O + prow((size_t)row) + colt + bj * HALF) = pack8(v0, v1); } }
        } else if (pn < 16 || (pn == 16 && wc < 2)) {
            const bool isq = pn < 16; const int head = isq ? 4 * (pn - 12) + wc : wc, i0 = 8 * fq;
            bf16_t* O = isq ? SQ : SK; const float sc = isq ? 0.125f * 1.4426950408889634f : 1.0f;
#pragma unroll
            for (int ai = 0; ai < 2; ++ai)
#pragma unroll
                for (int m = 0; m < 4; ++m) { const int row = row0 + ai * HALF + m * 16;
                    f32x4 o1[2], o2[2];
#pragma unroll
                    for (int n = 0; n < 2; ++n) { const f32x4 c = *(const PG8_GAS f32x4*)(coss + (size_t)row * 32 + i0 + 4 * n), s = *(const PG8_GAS f32x4*)(sins + (size_t)row * 32 + i0 + 4 * n);
                        const f32x4 x1 = acc[ai][0][m][n], x2 = acc[ai][1][m][n]; o1[n] = (x1 * c - x2 * s) * sc; o2[n] = (x2 * c + x1 * s) * sc; }
                    bf16_t* p = O + (isq ? prow((size_t)row) : (size_t)row * 128) + head * 64 + i0; *(PG8_GAS u32x4*)p = pack8(o1[0], o1[1]); *(PG8_GAS u32x4*)(p + 32) = pack8(o2[0], o2[1]); if (m & 1) asm volatile("" ::: "memory"); }
        } else if (pn == 16) {
            const int jj = (wc - 2) * 32 + 8 * fq;
#pragma unroll
            for (int ai = 0; ai < 2; ++ai)
#pragma unroll
                for (int m = 0; m < 4; ++m) { const int row = row0 + ai * HALF + m * 16;
#pragma unroll
                    for (int bj = 0; bj < 2; ++bj) *(PG8_GAS u32x4*)(SV + (size_t)row * 128 + bj * 64 + jj) = pack8(acc[ai][bj][m][0], acc[ai][bj][m][1]); }
        } else {
            bf16_t* O = pn >= 21 ? GS : GR; const int colt = ((pn - 17) & 3) * 256 + j0;
#pragma unroll
            for (int ai = 0; ai < 2; ++ai)
#pragma unroll
                for (int m = 0; m < 4; ++m) { const int row = row0 + ai * HALF + m * 16;
#pragma unroll
                    for (int bj = 0; bj < 2; ++bj) { f32x4 v0 = acc[ai][bj][m][0], v1 = acc[ai][bj][m][1];
#pragma unroll
#ifndef DBG_RAW_GATES
                        for (int e = 0; e < 4; ++e) { v0[e] = fsigmoid(v0[e]); v1[e] = fsigmoid(v1[e]); }
#else
                        for (int e = 0; e < 4; ++e) { v0[e] = v0[e] * 0.25f; v1[e] = v1[e] * 0.25f; }
#endif
                        *(PG8_GAS u32x4*)(O + (size_t)row * 1024 + colt + bj * HALF) = pack8(v0, v1); } }
        }
    }
};
}
#define GAS __attribute__((address_space(1)))
#define LAS __attribute__((address_space(3)))
typedef unsigned short bf16;
typedef unsigned v4u __attribute__((ext_vector_type(4)));
typedef float f32x4 __attribute__((ext_vector_type(4)));
typedef short bf16x8 __attribute__((ext_vector_type(8)));
typedef GAS unsigned gu32;
typedef GAS unsigned long long gu64;
#define RLX_AGENT __ATOMIC_RELAXED, __HIP_MEMORY_SCOPE_AGENT
#define LDS_WAIT() asm volatile("s_waitcnt lgkmcnt(0)" ::: "memory")
#define VM_WAIT() asm volatile("s_waitcnt vmcnt(0)" ::: "memory")
__device__ __forceinline__ unsigned long long rt() { return __builtin_amdgcn_s_memrealtime(); }
__device__ __forceinline__ unsigned f2bf(float f) { unsigned u = __builtin_bit_cast(unsigned, f); return (u + 0x7fffu + ((u >> 16) & 1u)) >> 16; }
__device__ __forceinline__ unsigned pk2(float lo, float hi) { return f2bf(lo) | (f2bf(hi) << 16); }

#define XB_TMO      128
#define XB_XCNT(j)  (256  + 64 * (j))
#define XB_XSUB(j)  (1280 + 64 * (j))
#define XB_XGEN(j)  (2304 + 64 * (j))
#define XB_TOP      3328
#define XB_TOPGEN   3392
#define XCD_BAR_WORDS 3456
#define XB_SPIN_CAP (1u << 18)

__device__ __forceinline__ unsigned xb_ld(unsigned* p)              { return __hip_atomic_load(p, __ATOMIC_RELAXED, __HIP_MEMORY_SCOPE_AGENT); }
__device__ __forceinline__ unsigned xb_add(unsigned* p, unsigned v) { return __hip_atomic_fetch_add(p, v, __ATOMIC_RELAXED, __HIP_MEMORY_SCOPE_AGENT); }
__device__ __forceinline__ unsigned xb_xcc_id() { return (unsigned)__builtin_amdgcn_s_getreg((3 << 11) | 20) & 0xFu; }
#define XB_SPIN(cond, bar) do { unsigned _sp = 0; while (cond) { __builtin_amdgcn_s_sleep(1); \
    if ((++_sp & 255u) == 0u) { if (xb_ld(&(bar)[XB_TMO])) break; if (_sp > XB_SPIN_CAP) { atomicAdd(&(bar)[XB_TMO], 1u); break; } } } } while (0)

__device__ __forceinline__ int xb_lane_id() { int l_; asm volatile("v_mbcnt_lo_u32_b32 %0, -1, 0\n\tv_mbcnt_hi_u32_b32 %0, -1, %0" : "=v"(l_)); return l_; }
struct XcdBarrier {
    unsigned w0;
    unsigned* bar; unsigned x;
    volatile LAS unsigned* st;
};

__device__ __forceinline__ XcdBarrier xcd_barrier_post(unsigned* bar, volatile LAS unsigned* st) {
    XcdBarrier b; b.w0 = 0u; b.bar = bar; b.x = xb_xcc_id(); b.st = st;
    if (threadIdx.x == 0) (void)xb_add(&bar[XB_XCNT(b.x)], 1u);
    return b;
}
__device__ __forceinline__ void xcd_barrier_complete(unsigned* bar, unsigned x, unsigned& nloc, unsigned& nx) {
    const unsigned G = gridDim.x * gridDim.y * gridDim.z;
    unsigned sum, cnt, mine, sp = 0u;
    for (;;) {
        sum = 0u; cnt = 0u; mine = 0u;
#pragma unroll
        for (unsigned j = 0; j < 16; ++j) { const unsigned c = xb_ld(&bar[XB_XCNT(j)]); sum += c; cnt += (c > 0u) ? 1u : 0u; mine = (j == x) ? c : mine; }
        if (sum == G) break;
        __builtin_amdgcn_s_sleep(1);
        if ((++sp & 255u) == 0u) { if (xb_ld(&bar[XB_TMO])) break; if (sp > XB_SPIN_CAP) { atomicAdd(&bar[XB_TMO], 1u); break; } }
    }
    nloc = mine > 0u ? mine : 1u; nx = cnt > 0u ? cnt : 1u;
}

__device__ __forceinline__ void xcd_barrier(const XcdBarrier& b) {
    asm volatile("s_waitcnt vmcnt(0)" ::: "memory");
    __syncthreads();
    if (b.w0 == 0u && xb_lane_id() == 0) {
        unsigned* bar = b.bar;
        __builtin_amdgcn_s_waitcnt(0);
        unsigned nloc = b.st[0], nx = b.st[1];
        if (nloc == 0u) { xcd_barrier_complete(bar, b.x, nloc, nx); b.st[0] = nloc; b.st[1] = nx; }
        const unsigned old = xb_add(&bar[XB_XSUB(b.x)], 1u);
        const unsigned gen = old / nloc;
        if (old + 1u == (gen + 1u) * nloc) {
            __builtin_amdgcn_fence(__ATOMIC_RELEASE, "agent");
            asm volatile("s_waitcnt vmcnt(0)" ::: "memory");
            const unsigned og = xb_add(&bar[XB_TOP], 1u);
            const unsigned tg = og / nx;
            if (og + 1u == (tg + 1u) * nx) xb_add(&bar[XB_TOPGEN], 1u);
            else XB_SPIN(xb_ld(&bar[XB_TOPGEN]) == tg, bar);
            __builtin_amdgcn_fence(__ATOMIC_ACQUIRE, "agent");
            xb_add(&bar[XB_XGEN(b.x)], 1u);
            asm volatile("s_waitcnt vmcnt(0)" ::: "memory");
        } else {
            XB_SPIN(xb_ld(&bar[XB_XGEN(b.x)]) == gen, bar);
            __builtin_amdgcn_fence(__ATOMIC_ACQUIRE, "agent");
            asm volatile("s_waitcnt vmcnt(0)" ::: "memory");
        }
    }
    __syncthreads();
}

struct GroupBar { unsigned* cnt; unsigned epoch; unsigned same_xcd; unsigned w0; unsigned next_same; };
__device__ __forceinline__ void group_barrier(GroupBar& gb, unsigned* tmo, unsigned* xcnt = nullptr, unsigned xwant = 0u, unsigned* nbr = nullptr, bool pub_next = false) {
    asm volatile("s_waitcnt vmcnt(0)" ::: "memory");
    __syncthreads();
    gb.epoch += 1u;
    if (gb.w0 == 0u && xb_lane_id() == 0) {
        if (!gb.same_xcd || (pub_next && !gb.next_same)) { __builtin_amdgcn_fence(__ATOMIC_RELEASE, "agent"); asm volatile("s_waitcnt vmcnt(0)" ::: "memory"); }
        (void)xb_add(gb.cnt, 1u);
        const unsigned want = 4u * gb.epoch; unsigned sp = 0u;
        while (xb_ld(gb.cnt) < want) { __builtin_amdgcn_s_sleep(1); if ((++sp & 255u) == 0u) { if (xb_ld(tmo)) break; if (sp > XB_SPIN_CAP) { atomicAdd(tmo, 1u); break; } } }
        if (nbr) { sp = 0u; while (xb_ld(nbr) < want) { __builtin_amdgcn_s_sleep(1); if ((++sp & 255u) == 0u) { if (xb_ld(tmo)) break; if (sp > XB_SPIN_CAP) { atomicAdd(tmo, 1u); break; } } } }
        if (xcnt) { sp = 0u; while (xb_ld(xcnt) < xwant) { __builtin_amdgcn_s_sleep(1); if ((++sp & 255u) == 0u) { if (xb_ld(tmo)) break; if (sp > XB_SPIN_CAP) { atomicAdd(tmo, 1u); break; } } } }
        __builtin_amdgcn_fence(__ATOMIC_ACQUIRE, "agent");
        asm volatile("s_waitcnt vmcnt(0)" ::: "memory");
    }
    __syncthreads();
}
constexpr int NWAVES = 8, NTHREADS = 512;
#ifndef MK_ONE_LAUNCH
#define MK_ONE_LAUNCH 1
#endif
#ifndef EN_FFN1
#define EN_FFN1 1
#endif
#ifndef EN_MIX
#define EN_MIX 1
#endif
#ifndef EN_FFN2
#define EN_FFN2 1
#endif
constexpr int BATCH = 2, T = 8192, D = 1024, M = BATCH * T, FF = 2816, NUP = 2 * FF, NIN = 6400, NMOD = 9 * D, DEPTH = 2;
constexpr float NORM_EPS = 1e-6f;
constexpr size_t MiB = 1u << 20;
constexpr size_t WS_CTL = 0, CTL_ZERO_BYTES = 64 * 1024;
constexpr size_t WS_MOD = 1 * MiB;
constexpr size_t WS_SS = 1 * MiB + 256 * 1024;
constexpr size_t WS_T = WS_SS + 6 * 65536;
constexpr int T_LD = 6400; constexpr size_t ZERO_BYTES = 768 * 1024;
static_assert(WS_T + (size_t)12 * T_LD * 4 <= WS_SS + ZERO_BYTES && WS_SS + ZERO_BYTES <= 2 * MiB, "ws map (SS, T)");
constexpr size_t WS_COSR = 2 * MiB, WS_SINR = 6 * MiB;
constexpr size_t WS_COSS = 10 * MiB, WS_SINS = 12 * MiB;
constexpr size_t WS_WUP1 = 14 * MiB, WS_WDN1 = 25 * MiB, WS_WIN = WS_WDN1 + 5767168, WS_WBR = 43 * MiB, WS_WBS = 45 * MiB, WS_WOUT = 47 * MiB, WS_WUP2 = 49 * MiB, WS_WDN2 = 60 * MiB;
constexpr size_t WS_XN = 66 * MiB;
constexpr size_t WS_RQ = 98 * MiB, WS_RK = 114 * MiB, WS_RV = 130 * MiB, WS_RG = WS_RV + 512 * 1024, WS_SQ = WS_RV + 1024 * 1024, WS_SK = 226 * MiB, WS_SV = 230 * MiB, WS_GR = 234 * MiB, WS_GS = 266 * MiB;
static_assert(WS_RV + (size_t)(M / 256) * pg8::PSTR * 2 <= WS_SK && pg8::PSTR * 2 == 3 * 512 * 1024 && (size_t)256 * FF * 2 <= pg8::PSTR * 2, "ws map (panel blocks)");
constexpr size_t WS_H = WS_RV;
constexpr int CW_CNV = 13312;
constexpr size_t WS_TMP = 298 * MiB;
constexpr size_t WS_MG = 298 * MiB;
constexpr size_t WS_KV = 298 * MiB;
constexpr size_t WS_END = 330 * MiB;
static_assert(WS_WIN + (size_t)NIN * D * 2 <= WS_WBR && WS_WDN2 + (size_t)D * FF * 2 <= WS_XN && WS_GS + (size_t)M * D * 2 <= WS_KV, "ws map");
constexpr int CW_BAR = 1024, CW_GRP = 8192, CW_XID = 12800;
constexpr int CW_BAR_ = 1024;
constexpr int LDS_BYTES = 163840, MISC_OFF = 156 * 1024;

struct Frame { LAS unsigned char* lds; int tid, lane, wave, vcu, G, w0; };

__device__ __forceinline__ float wave_sum(float v) {
#pragma unroll
    for (int o = 1; o < 64; o <<= 1) v += __shfl_xor(v, o);
    return v;
}
__device__ __forceinline__ float lg2gamma(int h) { return __log2f(1.0f - __builtin_amdgcn_exp2f(-5.0f - (float)h)); }
__device__ __forceinline__ float bf2f(unsigned short b) { return __uint_as_float((unsigned)b << 16); }

constexpr int CV_SCR = 16896;
template <bool WTH = false> __device__ __forceinline__ void conv_item(const float* W, int ldw, int k0, int nsrc_lane, bf16* WT, int ldk, int drow0, LAS float* scr, int lane, float* tacc = nullptr, const float* sh = nullptr) {
    const GAS float* wp = (const GAS float*)W + (size_t)k0 * ldw + nsrc_lane;
    float v[64];
#pragma unroll
    for (int kk = 0; kk < 64; ++kk) v[kk] = __builtin_nontemporal_load(wp + (size_t)kk * ldw);
#pragma unroll
    for (int kk = 0; kk < 64; ++kk) scr[kk * 65 + lane] = v[kk];
    LDS_WAIT(); asm volatile("" ::: "memory");
    if (tacc) { float t0 = 0.f, t1 = 0.f; const GAS float* s0 = (const GAS float*)sh + k0; const GAS float* s1 = s0 + NMOD;
#pragma unroll 16
        for (int kk = 0; kk < 64; ++kk) { const float w = scr[kk * 65 + lane]; t0 += s0[kk] * w; t1 += s1[kk] * w; }
        (void)__hip_atomic_fetch_add((GAS float*)tacc + drow0 + lane, t0, __ATOMIC_RELAXED, __HIP_MEMORY_SCOPE_AGENT); (void)__hip_atomic_fetch_add((GAS float*)tacc + T_LD + drow0 + lane, t1, __ATOMIC_RELAXED, __HIP_MEMORY_SCOPE_AGENT); }
    const int c = lane & 7;
#pragma unroll
    for (int j = 0; j < 8; ++j) { const int n = (lane >> 3) + 8 * j; const LAS float* s = scr + (8 * c) * 65 + n;
        v4u o; o.x = pk2(s[0 * 65], s[1 * 65]); o.y = pk2(s[2 * 65], s[3 * 65]); o.z = pk2(s[4 * 65], s[5 * 65]); o.w = pk2(s[6 * 65], s[7 * 65]);
        GAS v4u* dp = (GAS v4u*)(WT + (size_t)(drow0 + n) * ldk + k0 + 8 * c);
        if (WTH) asm volatile("global_store_dwordx4 %0, %1, off sc1" :: "v"(dp), "v"(o) : "memory"); else *dp = o; }
    LDS_WAIT(); asm volatile("" ::: "memory");
}
__device__ __forceinline__ int map_up(int g) { const int c = 32 * g, pn = c >> 8, bj = (c >> 7) & 1, j = c & 127; return bj * FF + 128 * pn + j; }
__device__ __forceinline__ int map_in(int g) {
    const int c = 32 * g, pn = c >> 8, bj = (c >> 7) & 1, j = c & 127;
    if (pn < 2)  return 0    + (2 * pn + (j >> 6)) * 128 + bj * 64 + (j & 63);
    if (pn < 4)  return 512  + (2 * (pn - 2) + (j >> 6)) * 128 + bj * 64 + (j & 63);
    if (pn < 8)  return 1024 + (pn - 4) * 256 + bj * 128 + j;
    if (pn < 12) return 2048 + (pn - 8) * 256 + bj * 128 + j;
    if (pn < 16) return 3072 + (4 * (pn - 12) + (j >> 5)) * 64 + bj * 32 + (j & 31);
    if (pn == 16) return j < 64 ? 4096 + (j >> 5) * 64 + bj * 32 + (j & 31) : 4224 + bj * 64 + (j - 64);
    if (pn < 21) return 4352 + (pn - 17) * 256 + bj * 128 + j;
    return 5376 + (pn - 21) * 256 + bj * 128 + j;
}
struct LayerW { const float *up1, *dn1, *win, *wbr, *wbs, *wout, *up2, *dn2; float* T; const float* mod; bool t_up1; };
constexpr int CI_UP = 16 * 88, CI_DN = 44 * 16, CI_IN = 16 * 100, CI_SQ = 16 * 16;
constexpr int CV_A0 = 0, CV_A1 = CI_UP + CI_DN, CV_B0 = CV_A1, CV_B1 = CV_B0 + CI_IN + 3 * CI_SQ, CV_C0 = CV_B1, CV_C1 = CV_C0 + CI_UP + CI_DN;
template <bool WTH = false> __device__ __forceinline__ void conv_items(Frame& F, const LayerW& W, unsigned char* ws, int first, int last, int wid, int nw) {
    LAS float* scr = (LAS float*)(F.lds + F.wave * CV_SCR);
    const int hh = F.lane >> 5, l31 = F.lane & 31;
    for (int it = first + wid; it < last; it += nw) {
        int r = it;
        if (r < CI_UP) { const int kb = r / 88, g = r % 88; conv_item<WTH>(W.up1, NUP, 64 * kb, map_up(2 * g + hh) + l31, (bf16*)(ws + WS_WUP1), D, 64 * g, scr, F.lane, (W.T && W.t_up1) ? W.T : nullptr, W.mod + 0 * D); continue; } r -= CI_UP;
        if (r < CI_DN) { const int kb = r / 16, g = r % 16; conv_item<WTH>(W.dn1, D, 64 * kb, 64 * g + F.lane, (bf16*)(ws + WS_WDN1), FF, 64 * g, scr, F.lane); continue; } r -= CI_DN;
        if (r < CI_IN) { const int kb = r / 100, g = r % 100; conv_item<WTH>(W.win, NIN, 64 * kb, map_in(2 * g + hh) + l31, (bf16*)(ws + WS_WIN), D, 64 * g, scr, F.lane, W.T ? W.T + 2 * T_LD : nullptr, W.mod + 3 * D); continue; } r -= CI_IN;
        if (r < CI_SQ) { const int kb = r / 16, g = r % 16; conv_item<WTH>(W.wbr, D, 64 * kb, 64 * g + F.lane, (bf16*)(ws + WS_WBR), 2 * D, 64 * g, scr, F.lane); continue; } r -= CI_SQ;
        if (r < CI_SQ) { const int kb = r / 16, g = r % 16; conv_item<WTH>(W.wbs, D, 64 * kb, 64 * g + F.lane, (bf16*)(ws + WS_WBR) + D, 2 * D, 64 * g, scr, F.lane); continue; } r -= CI_SQ;
        if (r < CI_SQ) { const int kb = r / 16, g = r % 16; conv_item<WTH>(W.wout, D, 64 * kb, 64 * g + F.lane, (bf16*)(ws + WS_WOUT), D, 64 * g, scr, F.lane); continue; } r -= CI_SQ;
        if (r < CI_UP) { const int kb = r / 88, g = r % 88; conv_item<WTH>(W.up2, NUP, 64 * kb, map_up(2 * g + hh) + l31, (bf16*)(ws + WS_WUP2), D, 64 * g, scr, F.lane, W.T ? W.T + 4 * T_LD : nullptr, W.mod + 6 * D); continue; } r -= CI_UP;
        { const int kb = r / 16, g = r % 16; conv_item<WTH>(W.dn2, D, 64 * kb, 64 * g + F.lane, (bf16*)(ws + WS_WDN2), FF, 64 * g, scr, F.lane); }
    }
}
__device__ __forceinline__ void mod_rope_phase(Frame& F, const float* c, const float* w_ada, const float* b_ada, const int* positions, unsigned char* ws) {
    LAS float* cact = (LAS float*)(F.lds);
    LAS float* red = (LAS float*)(F.lds + 8192);
    float* MOD = (float*)(ws + WS_MOD);
    for (int t = F.tid; t < 2 * D; t += NTHREADS) { const float v = ((const GAS float*)c)[t]; cact[t] = v / (1.0f + __expf(-v)); }
    __syncthreads();
    for (int item = F.vcu; item < 256; item += F.G) {
        const int l = item >> 7, n0 = (item & 127) * 72, kg = F.tid / 18, cl = F.tid % 18;
        f32x4 a0 = {0.f, 0.f, 0.f, 0.f}, a1 = {0.f, 0.f, 0.f, 0.f};
        if (F.tid < 504) {
            const float* wp = w_ada + (size_t)l * D * NMOD + n0 + 4 * cl;
#pragma unroll 4
            for (int k = kg; k < D; k += 28) { const f32x4 w = __builtin_nontemporal_load((const GAS f32x4*)(wp + (size_t)k * NMOD)); a0 += w * cact[k]; a1 += w * cact[D + k]; }
            LAS float* rp = red + (kg * 18 + cl) * 8;
#pragma unroll
            for (int e = 0; e < 4; ++e) { rp[e] = a0[e]; rp[4 + e] = a1[e]; }
        }
        __syncthreads();
        if (F.tid < 144) { const int cl2 = F.tid >> 3, comp = F.tid & 7, b = comp >> 2, e = comp & 3; float s = 0.f;
            for (int g = 0; g < 28; ++g) s += red[(g * 18 + cl2) * 8 + comp];
            ((GAS float*)MOD)[(size_t)(l * 2 + b) * NMOD + n0 + 4 * cl2 + e] = s + ((const GAS float*)b_ada)[(size_t)l * NMOD + n0 + 4 * cl2 + e]; }
        __syncthreads();
    }
    GAS float* cosr = (GAS float*)(ws + WS_COSR); GAS float* sinr = (GAS float*)(ws + WS_SINR); GAS float* coss = (GAS float*)(ws + WS_COSS); GAS float* sins = (GAS float*)(ws + WS_SINS);
    const int gt = F.vcu * NTHREADS + F.tid, NGT = F.G * NTHREADS;
    for (int idx = gt; idx < M * 64; idx += NGT) {
        const int row = idx >> 6, i = idx & 63; const float pos = (float)((const GAS int*)positions)[row];
        const float inv = (float)exp2(-(double)i * (13.287712379549449 / 64.0));
        const double a = (double)(pos * inv), n = rint(a * 0.15915494309189535), r = a - n * 6.283185307179586;
        const float rf = (float)r; cosr[idx] = cosf(rf); sinr[idx] = sinf(rf);
        if (!(i & 1)) { const int o = row * 32 + (i >> 1); coss[o] = cosf(rf); sins[o] = sinf(rf); }
    }
}
constexpr int NORM_NB = 8;
__device__ __forceinline__ void norm_phase(Frame& F, const float* xin, const float* gain, const float* shift, const float* scale, bf16* XN, int row_lo, int row_hi) {
    const GAS f32x4* g4 = (const GAS f32x4*)gain + F.lane;
    const int bo = (row_lo >= T) ? NMOD : 0;
    const GAS f32x4* sh4 = (const GAS f32x4*)(shift + bo) + F.lane; const GAS f32x4* sc4 = (const GAS f32x4*)(scale + bo) + F.lane;
    f32x4 w4[4], s4[4];
#pragma unroll
    for (int j = 0; j < 4; ++j) { w4[j] = g4[64 * j] * (sc4[64 * j] + 1.0f); s4[j] = sh4[64 * j]; }
    for (int m0 = row_lo + F.wave * NORM_NB; m0 < row_hi; m0 += NWAVES * NORM_NB) {
        f32x4 v[NORM_NB][4];
#pragma unroll
        for (int r = 0; r < NORM_NB; ++r) { const GAS f32x4* xr = (const GAS f32x4*)(xin + (size_t)(m0 + r) * D) + F.lane;
#pragma unroll
            for (int j = 0; j < 4; ++j) v[r][j] = xr[64 * j]; }
#pragma unroll
        for (int r = 0; r < NORM_NB; ++r) { float s = 0.f;
#pragma unroll
            for (int j = 0; j < 4; ++j) s += (v[r][j].x * v[r][j].x + v[r][j].y * v[r][j].y) + (v[r][j].z * v[r][j].z + v[r][j].w * v[r][j].w);
            const float rstd = 1.0f / sqrtf(wave_sum(s) * (1.0f / D) + NORM_EPS);
            GAS unsigned long long* o8 = (GAS unsigned long long*)(XN + (size_t)(m0 + r) * D) + F.lane;
#pragma unroll
            for (int j = 0; j < 4; ++j) { const f32x4 o = (v[r][j] * rstd) * w4[j] + s4[j];
                o8[64 * j] = (unsigned long long)pk2(o.x, o.y) | ((unsigned long long)pk2(o.z, o.w) << 32); } }
    }
}
typedef _Float16 f16x8 __attribute__((ext_vector_type(8)));
typedef float f32x8 __attribute__((ext_vector_type(8)));
constexpr int XPITCH = 2048;
__device__ __forceinline__ void final_norm_phase(Frame& F, float* out, const float* gain, int row_lo, int row_hi) {
    const GAS f32x4* g4 = (const GAS f32x4*)gain;
    f32x4 w4[4];
#pragma unroll
    for (int j = 0; j < 4; ++j) w4[j] = g4[(j >> 1) * 128 + 2 * F.lane + (j & 1)];
    for (int m0 = row_lo + F.wave * NORM_NB; m0 < row_hi; m0 += NWAVES * NORM_NB) {
        f16x8 hv[NORM_NB][2];
#pragma unroll
        for (int r = 0; r < NORM_NB; ++r) { const GAS f16x8* xr = (const GAS f16x8*)((const _Float16*)out + (size_t)(m0 + r) * XPITCH) + F.lane; hv[r][0] = __builtin_nontemporal_load(xr); hv[r][1] = __builtin_nontemporal_load(xr + 64); }
#pragma unroll
        for (int r = 0; r < NORM_NB; ++r) { const f32x8 a = __builtin_convertvector(hv[r][0], f32x8), b = __builtin_convertvector(hv[r][1], f32x8); float s = 0.f;
#pragma unroll
            for (int e = 0; e < 8; ++e) s += a[e] * a[e] + b[e] * b[e];
            const float rstd = 1.0f / sqrtf(wave_sum(s) * (1.0f / D) + NORM_EPS);
            GAS f32x4* o = (GAS f32x4*)(out + (size_t)(m0 + r) * D);
            __builtin_nontemporal_store((f32x4){a[0], a[1], a[2], a[3]} * rstd * w4[0], o + 2 * F.lane); __builtin_nontemporal_store((f32x4){a[4], a[5], a[6], a[7]} * rstd * w4[1], o + 2 * F.lane + 1);
            __builtin_nontemporal_store((f32x4){b[0], b[1], b[2], b[3]} * rstd * w4[2], o + 128 + 2 * F.lane); __builtin_nontemporal_store((f32x4){b[4], b[5], b[6], b[7]} * rstd * w4[3], o + 128 + 2 * F.lane + 1); }
    }
}
typedef short s16x4 __attribute__((ext_vector_type(4)));
typedef unsigned v2u __attribute__((ext_vector_type(2)));
#define MFMA16(x, y, c) __builtin_amdgcn_mfma_f32_16x16x32_bf16((x), (y), (c), 0, 0, 0)
__device__ __forceinline__ s16x4 tr_read(LAS const unsigned char* p) { return __builtin_bit_cast(s16x4, __builtin_amdgcn_ds_read_tr16_b64_v4i16((LAS s16x4*)p)); }
__device__ __forceinline__ bf16x8 frag_nat(LAS const unsigned char* base, int RS, int r0, int k0, int lane) { return *(LAS const bf16x8*)(base + (r0 + (lane & 15)) * RS + (k0 + 8 * (lane >> 4)) * 2); }
__device__ __forceinline__ bf16x8 frag_tr(LAS const unsigned char* base, int RS, int klo, int khi, int c0, int lane) {
    const int i = lane & 15, q = i >> 2, p = i & 3;
    const s16x4 lo = tr_read(base + (klo + q) * RS + (c0 + 4 * p) * 2), hi = tr_read(base + (khi + q) * RS + (c0 + 4 * p) * 2);
    return (bf16x8){lo[0], lo[1], lo[2], lo[3], hi[0], hi[1], hi[2], hi[3]};
}
__device__ __forceinline__ void stage_tile(LAS unsigned char* dst, int RS, const bf16* src, size_t gstride, int rows, int cpr_log2, int tid) {
    const int total = rows << cpr_log2;
    for (int c = tid; c < total; c += NTHREADS) { const int r = c >> cpr_log2, cc = c & ((1 << cpr_log2) - 1);
        const v4u v = *(const GAS v4u*)(src + (size_t)r * gstride + cc * 8); *(LAS v4u*)(dst + r * RS + cc * 16) = v; }
}
__device__ __forceinline__ unsigned pkbf(float lo, float hi) { return pg8::cvt_pk_bf16(lo, hi); }

constexpr int RS_QK = 272, RS_V = 528;
template <int ROWS, int CPRL> struct TileRegs { static constexpr int NCH = (ROWS << CPRL) / NTHREADS; v4u v[NCH]; };
template <int ROWS, int CPRL, bool NT = false> __device__ __forceinline__ void tile_load(TileRegs<ROWS, CPRL>& t, const bf16* src, int gstride, int tid) {
    const unsigned off0 = (unsigned)(tid >> CPRL) * (unsigned)(gstride * 2) + (unsigned)(tid & ((1 << CPRL) - 1)) * 16u;
    const GAS unsigned char* s = (const GAS unsigned char*)src;
#pragma unroll
    for (int k = 0; k < TileRegs<ROWS, CPRL>::NCH; ++k) { const GAS v4u* p = (const GAS v4u*)(s + off0 + (unsigned)k * (unsigned)((NTHREADS >> CPRL) * gstride * 2)); t.v[k] = NT ? __builtin_nontemporal_load(p) : *p; }
}
template <int ROWS, int CPRL> __device__ __forceinline__ void tile_store(const TileRegs<ROWS, CPRL>& t, LAS unsigned char* dst, int RS, int tid) {
    const int off0 = (tid >> CPRL) * RS + (tid & ((1 << CPRL) - 1)) * 16;
#pragma unroll
    for (int k = 0; k < TileRegs<ROWS, CPRL>::NCH; ++k) *(LAS v4u*)(dst + off0 + k * ((NTHREADS >> CPRL) * RS)) = t.v[k];
}
__device__ __forceinline__ void kv_phase(Frame& F, const bf16* RK, const bf16* RV, bf16* KV, const int u_first, const int u_step, const int u_end) {
    const int lane = F.lane, w = F.wave, i = lane & 15, g = lane >> 4;
    LAS unsigned char* Ks = F.lds; LAS unsigned char* Vs = F.lds + 128 * RS_QK;
    TileRegs<128, 4> tk; TileRegs<128, 5> tv;
    int u = u_first;
    if (u < u_end) { const int b = u >> 8, n = (u >> 2) & 63, h = u & 3; const size_t row0 = (size_t)b * T + n * 128;
        tile_load(tk, RK + row0 * 512 + h * 128, 512, F.tid); tile_load(tv, RV + pg8::prow(row0) + h * 256, 1024, F.tid); }
    while (u < u_end) {
        const int h = u & 3;
        tile_store(tk, Ks, RS_QK, F.tid); tile_store(tv, Vs, RS_V, F.tid);
        __syncthreads();
        const int un = u + u_step;
        if (un < u_end) { const int b = un >> 8, n = (un >> 2) & 63, hn = un & 3; const size_t row0 = (size_t)b * T + n * 128;
            tile_load(tk, RK + row0 * 512 + hn * 128, 512, F.tid); tile_load(tv, RV + pg8::prow(row0) + hn * 256, 1024, F.tid); }
        f32x4 acc[16];
#pragma unroll
        for (int t = 0; t < 16; ++t) acc[t] = (f32x4){0.f, 0.f, 0.f, 0.f};
#pragma unroll
        for (int s = 0; s < 4; ++s) {
            const bf16x8 y = frag_tr(Ks, RS_QK, 32 * s + 8 * g, 32 * s + 8 * g + 4, 16 * w, lane);
#pragma unroll
            for (int t = 0; t < 16; ++t) { const bf16x8 x = frag_tr(Vs, RS_V, 32 * s + 8 * g, 32 * s + 8 * g + 4, 16 * t, lane); acc[t] = MFMA16(x, y, acc[t]); }
        }
        const float sc = __builtin_amdgcn_exp2f(127.0f * lg2gamma(h));
        bf16* o = KV + (size_t)u * 32768 + (16 * w + i) * 256 + 4 * g;
#pragma unroll
        for (int t = 0; t < 16; ++t) { const f32x4 v = acc[t] * sc; *(GAS v2u*)(o + 16 * t) = (v2u){pkbf(v[0], v[1]), pkbf(v[2], v[3])}; }
        __syncthreads();
        u = un;
    }
}
__device__ __forceinline__ void scan_phase(Frame& F, bf16* KV) {
    const int gt = F.vcu * NTHREADS + F.tid, NGT = F.G * NTHREADS;
    for (int idx = gt; idx < 8 * 16384; idx += NGT) {
        const int bh = idx >> 14, e2 = idx & 16383, b = bh >> 2, h = bh & 3;
        GAS unsigned* p = (GAS unsigned*)(KV + ((size_t)(b * 64) * 4 + h) * 32768) + e2;
        const float dec = __builtin_amdgcn_exp2f(128.0f * lg2gamma(h));
        float s0 = 0.f, s1 = 0.f;
#pragma unroll 1
        for (int n0 = 0; n0 < 64; n0 += 16) { unsigned v[16];
#pragma unroll
            for (int k = 0; k < 16; ++k) v[k] = __builtin_nontemporal_load(p + (size_t)(n0 + k) * 65536);
#pragma unroll
            for (int k = 0; k < 16; ++k) { p[(size_t)(n0 + k) * 65536] = pkbf(s0, s1); s0 = dec * s0 + __uint_as_float(v[k] << 16); s1 = dec * s1 + __uint_as_float(v[k] & 0xffff0000u); } }
    }
}
__device__ __forceinline__ void ret_phase(Frame& F, const bf16* RQ, const bf16* RK, const bf16* RV, bf16* RO, const bf16* RG, const bf16* KV, int u_first, int u_step, int u_end) {
    const int lane = F.lane, w = F.wave, i = lane & 15, g = lane >> 4;
    LAS unsigned char* Qs = F.lds; LAS unsigned char* Ks = F.lds + 128 * RS_QK; LAS unsigned char* Rs = F.lds + 256 * RS_QK;
    TileRegs<128, 4> tq, tk; TileRegs<128, 5> tr;
    int u = u_first;
    if (u < u_end) { const int b = u >> 8, n = (u >> 2) & 63, h = u & 3; const size_t row0 = (size_t)b * T + n * 128;
        tile_load<128, 4, true>(tq, RQ + row0 * 512 + h * 128, 512, F.tid); tile_load<128, 4, true>(tk, RK + row0 * 512 + h * 128, 512, F.tid); tile_load<128, 5, true>(tr, KV + (size_t)u * 32768, 256, F.tid); }
    while (u < u_end) {
        const int b = u >> 8, n = (u >> 2) & 63, h = u & 3; const size_t row0 = (size_t)b * T + n * 128;
        tile_store(tq, Qs, RS_QK, F.tid); tile_store(tk, Ks, RS_QK, F.tid); tile_store(tr, Rs, RS_V, F.tid);
        __syncthreads();
        tile_load<128, 5, true>(tr, RV + pg8::prow(row0) + h * 256, 1024, F.tid);
        f32x4 acc[16];
#pragma unroll
        for (int t = 0; t < 16; ++t) acc[t] = (f32x4){0.f, 0.f, 0.f, 0.f};
        bf16x8 yq[4];
#pragma unroll
        for (int s = 0; s < 4; ++s) yq[s] = frag_nat(Qs, RS_QK, 16 * w, 32 * s, lane);
#pragma unroll
        for (int s = 0; s < 4; ++s)
#pragma unroll
            for (int t = 0; t < 16; ++t) { const bf16x8 x = frag_tr(Rs, RS_V, 32 * s + 8 * g, 32 * s + 8 * g + 4, 16 * t, lane); acc[t] = MFMA16(x, yq[s], acc[t]); }
        const float gam = __builtin_amdgcn_exp2f(lg2gamma(h));
#pragma unroll
        for (int t = 0; t < 16; ++t) acc[t] *= gam;
        __builtin_amdgcn_sched_barrier(0);
        bf16x8 pf[4];
#pragma unroll
        for (int kp = 0; kp < 4; ++kp) {
            f32x4 sa = (f32x4){0.f, 0.f, 0.f, 0.f}, sb = (f32x4){0.f, 0.f, 0.f, 0.f};
            if (2 * kp <= w) {
#pragma unroll
                for (int s = 0; s < 4; ++s) { sa = MFMA16(frag_nat(Ks, RS_QK, 32 * kp, 32 * s, lane), yq[s], sa); sb = MFMA16(frag_nat(Ks, RS_QK, 32 * kp + 16, 32 * s, lane), yq[s], sb); }
            }
            const int ti = 16 * w + i, ja = 32 * kp + 4 * g, jb = ja + 16;
#pragma unroll
            for (int r = 0; r < 4; ++r) { if (ja + r > ti) sa[r] = 0.f; if (jb + r > ti) sb[r] = 0.f; }
            const unsigned p0 = pkbf(sa[0], sa[1]), p1 = pkbf(sa[2], sa[3]), p2 = pkbf(sb[0], sb[1]), p3 = pkbf(sb[2], sb[3]);
            pf[kp] = __builtin_bit_cast(bf16x8, (v4u){p0, p1, p2, p3});
        }
        __syncthreads();
        tile_store(tr, Rs, RS_V, F.tid);
        __syncthreads();
        const int un = u + u_step;
        const size_t ob = pg8::prow(row0 + 16 * w + i) + h * 256 + 4 * g;
        v2u gz[16];
#pragma unroll
        for (int t = 0; t < 16; ++t) gz[t] = __builtin_nontemporal_load((const GAS v2u*)(RG + ob + 16 * t));
#pragma unroll
        for (int kp = 0; kp < 4; ++kp) {
            if (2 * kp <= w) {
#pragma unroll
                for (int t = 0; t < 16; ++t) { const bf16x8 x = frag_tr(Rs, RS_V, 32 * kp + 4 * g, 32 * kp + 16 + 4 * g, 16 * t, lane); acc[t] = MFMA16(x, pf[kp], acc[t]); }
            }
        }
        asm volatile("" ::: "memory"); __builtin_amdgcn_sched_barrier(0);
        if (un < u_end) { const int bn = un >> 8, nn = (un >> 2) & 63, hn = un & 3; const size_t rown = (size_t)bn * T + nn * 128;
            tile_load<128, 4, true>(tq, RQ + rown * 512 + hn * 128, 512, F.tid); tile_load<128, 4, true>(tk, RK + rown * 512 + hn * 128, 512, F.tid); tile_load<128, 5, true>(tr, KV + (size_t)un * 32768, 256, F.tid); }
        float s = 0.f;
#pragma unroll
        for (int t = 0; t < 16; ++t) s += (acc[t][0] + acc[t][1]) + (acc[t][2] + acc[t][3]);
        s += __shfl_xor(s, 16); s += __shfl_xor(s, 32);
        const float mu = s * (1.0f / 256.0f); float q = 0.f;
#pragma unroll
        for (int t = 0; t < 16; ++t) { const f32x4 d = acc[t] - mu; q += (d[0] * d[0] + d[1] * d[1]) + (d[2] * d[2] + d[3] * d[3]); }
        q += __shfl_xor(q, 16); q += __shfl_xor(q, 32);
        const float rstd = 1.0f / sqrtf(q * (1.0f / 256.0f) + NORM_EPS);
#pragma unroll
        for (int t = 0; t < 16; ++t) {
            const float o0 = (acc[t][0] - mu) * rstd * __uint_as_float(gz[t].x << 16), o1 = (acc[t][1] - mu) * rstd * __uint_as_float(gz[t].x & 0xffff0000u);
            const float o2 = (acc[t][2] - mu) * rstd * __uint_as_float(gz[t].y << 16), o3 = (acc[t][3] - mu) * rstd * __uint_as_float(gz[t].y & 0xffff0000u);
            *(GAS v2u*)(RO + ob + 16 * t) = (v2u){pkbf(o0, o1), pkbf(o2, o3)}; }
        __syncthreads();
        u = un;
    }
}
constexpr int RS_S = 144;
__device__ __forceinline__ void swa_unit(Frame& F, int u, const bf16* SQ, bf16* SO, const bf16* SK, const bf16* SV, const float* sinks) {
    const int b = u >> 7, n = (u >> 1) & 63, kvh = u & 1, lane = F.lane, w = F.wave, i = lane & 15, g = lane >> 4;
    LAS unsigned char* Ks = F.lds; LAS unsigned char* Vs = F.lds + 272 * RS_S;
    const int hq = kvh * 8 + w;
    const bf16* qbase = SQ + pg8::prow((size_t)b * T + n * 128 + i) + hq * 64; bf16* obase = SO + pg8::prow((size_t)b * T + n * 128 + i) + hq * 64;
    bf16x8 yq0 = __builtin_nontemporal_load((const GAS bf16x8*)(qbase + 8 * g)), yq1 = __builtin_nontemporal_load((const GAS bf16x8*)(qbase + 32 + 8 * g));
    { v4u kv[5], vv[5];
#pragma unroll
        for (int k = 0; k < 5; ++k) { const int c = F.tid + k * NTHREADS, r = c >> 3, cc = c & 7; kv[k] = (v4u){0u, 0u, 0u, 0u}; vv[k] = kv[k];
            if (r < 256 && (n > 0 || r >= 128)) { const size_t tok = (size_t)b * T + (n - 1) * 128 + r; kv[k] = *(const GAS v4u*)(SK + tok * 128 + kvh * 64 + cc * 8); vv[k] = *(const GAS v4u*)(SV + tok * 128 + kvh * 64 + cc * 8); } }
#pragma unroll
        for (int k = 0; k < 5; ++k) { const int c = F.tid + k * NTHREADS, r = c >> 3, cc = c & 7; if (c < 272 * 8) { *(LAS v4u*)(Ks + r * RS_S + cc * 16) = kv[k]; *(LAS v4u*)(Vs + r * RS_S + cc * 16) = vv[k]; } } }
    __syncthreads();
    const float sink = ((const GAS float*)sinks)[hq] * 1.4426950408889634f;
    float am0[4], am8[4];
#pragma unroll
    for (int r = 0; r < 4; ++r) { am0[r] = (4 * g + r <= i) ? -INFINITY : 0.f; am8[r] = (4 * g + r > i) ? -INFINITY : 0.f; }
#pragma unroll 1
    for (int qb = 0; qb < 8; ++qb) {
        const bf16* qn = qbase + (size_t)(qb < 7 ? 16 * (qb + 1) : 16 * qb) * 1024;
        const bf16x8 nq0 = __builtin_nontemporal_load((const GAS bf16x8*)(qn + 8 * g)), nq1 = __builtin_nontemporal_load((const GAS bf16x8*)(qn + 32 + 8 * g));
        bf16* op = obase + (size_t)(16 * qb) * 1024;
        f32x4 st[10]; float mx = sink;
#pragma unroll
        for (int jt = 0; jt < 9; ++jt) { const int J = qb + jt;
            f32x4 a = (f32x4){0.f, 0.f, 0.f, 0.f};
            a = MFMA16(frag_nat(Ks, RS_S, 16 * J, 0, lane), yq0, a); a = MFMA16(frag_nat(Ks, RS_S, 16 * J, 32, lane), yq1, a);
            if (jt == 0) { a[0] += am0[0]; a[1] += am0[1]; a[2] += am0[2]; a[3] += am0[3]; }
            if (jt == 8) { a[0] += am8[0]; a[1] += am8[1]; a[2] += am8[2]; a[3] += am8[3]; }
            if (n == 0 && J < 8) a = (f32x4){-INFINITY, -INFINITY, -INFINITY, -INFINITY};
            mx = fmaxf(fmaxf(mx, fmaxf(a[0], a[1])), fmaxf(a[2], a[3]));
            st[jt] = a; }
        mx = fmaxf(mx, __shfl_xor(mx, 16)); mx = fmaxf(mx, __shfl_xor(mx, 32));
        float sum = 0.f;
#pragma unroll
        for (int jt = 0; jt < 9; ++jt)
#pragma unroll
            for (int r = 0; r < 4; ++r) { const float p = __builtin_amdgcn_exp2f(st[jt][r] - mx); st[jt][r] = p; sum += p; }
        st[9] = (f32x4){0.f, 0.f, 0.f, 0.f};
        sum += __shfl_xor(sum, 16); sum += __shfl_xor(sum, 32);
        const float inv = 1.0f / (sum + __builtin_amdgcn_exp2f(sink - mx));
        f32x4 o[4];
#pragma unroll
        for (int dt = 0; dt < 4; ++dt) o[dt] = (f32x4){0.f, 0.f, 0.f, 0.f};
#pragma unroll
        for (int kp = 0; kp < 5; ++kp) { const f32x4 pa = st[2 * kp], pb = st[2 * kp + 1];
            const bf16x8 pfr = __builtin_bit_cast(bf16x8, (v4u){pkbf(pa[0], pa[1]), pkbf(pa[2], pa[3]), pkbf(pb[0], pb[1]), pkbf(pb[2], pb[3])});
            const int ka = 16 * (qb + 2 * kp) + 4 * g;
#pragma unroll
            for (int dt = 0; dt < 4; ++dt) { const bf16x8 x = frag_tr(Vs, RS_S, ka, ka + 16, 16 * dt, lane); o[dt] = MFMA16(x, pfr, o[dt]); } }
#pragma unroll
        for (int dt = 0; dt < 4; ++dt) { const f32x4 ov = o[dt] * inv; *(GAS v2u*)(op + 16 * dt + 4 * g) = (v2u){pkbf(ov[0], ov[1]), pkbf(ov[2], ov[3])}; }
        yq0 = nq0; yq1 = nq1;
    }
    __syncthreads();
}
#ifndef DBG_P11_A
#define DBG_P11_A WS_XN
#endif
#ifndef PH_MASK
#define PH_MASK 0xFFFF
#endif
#define PH_ON(s) (((PH_MASK) >> (s)) & 1)
struct Args { const void* in[18]; float* out; unsigned char* ws; int ph_lo, ph_hi; };
constexpr int PH_PER_LAYER = 15, N_PHASES = DEPTH * PH_PER_LAYER + 1;
#ifndef PROBE_GB
#define PROBE_GB 0
#endif
#ifndef WT_A0
#define WT_A0 false
#endif
#ifndef WT_C
#define WT_C false
#endif
#ifndef GEMM_SP2
#define GEMM_SP2 true
#endif
#ifndef DBG_REP
#define DBG_REP 0
#endif
#ifndef USE_GROUP_BAR
#define USE_GROUP_BAR 1
#endif
#if DBG_REP
#define COEF_(x) (dry ? 0.0f : (x))
#define XBSEL_(p) (dry ? (bf16*)nullptr : (p))
#else
#define COEF_(x) (x)
#define XBSEL_(p) (p)
#endif
#define PH_BEGIN(k) if (PH_ON((k) % 15 + ((k) == 30 ? 15 : 0)) && lo <= (k) && (k) < hi) { \
      for (int rep_ = ((DBG_REP >> ((k) % 15)) & 1) && (k) != 30 ? 1 : 0; rep_ >= 0; --rep_) { const bool dry = rep_ > 0; (void)dry; \
        { const int t_ = F.w0 * 64 + xb_lane_id(); F.tid = t_; F.lane = t_ & 63; F.wave = F.w0; } \
        unsigned char* ws = ws_; asm volatile("" : "+s"(ws));
#define PH_END(k) if ((k) + 1 < hi || rep_ > 0) xcd_barrier(bar); } }
#define PH_END_GROUP(k) if (rep_ > 0) xcd_barrier(bar); else if ((k) + 1 < hi) { if (USE_GROUP_BAR) group_barrier(gb, tmo_); else xcd_barrier(bar); } } }
#define PH_END_SEL(k, grid) if (rep_ > 0) xcd_barrier(bar); else if ((k) + 1 < hi) { if ((grid) || !USE_GROUP_BAR) xcd_barrier(bar); else group_barrier(gb, tmo_); } } }
#define PH_END_NONE(k) if (rep_ > 0) xcd_barrier(bar); } }
#define COMMA_ ,
#define GEMM_PHASE_PF(EPI, Aptr, Wptr, Ncols, Kdim, PFptr, PFpitch, ...) do { pg8::Gemm g{(const bf16*)(Aptr), (const bf16*)(Wptr), M, (Ncols), (Kdim)}; g.pf = (PFptr); g.pf_pitch = (PFpitch); pg8::StaticOrder S; S.init(M, (Ncols), F.G, (int)blockIdx.x); \
        EPI E{__VA_ARGS__}; pg8::gemm_phase<EPI, pg8::StaticOrder, true, GEMM_SP2>(F.lds, g, S, E, F.w0); } while (0)
#define GEMM_PHASE_PFS(EPI, Aptr, Wptr, Ncols, Kdim, PFptr, PFpitch, ...) do { pg8::Gemm g{(const bf16*)(Aptr), (const bf16*)(Wptr), M, (Ncols), (Kdim)}; g.a_tile = pg8::PSTR * 2; g.pf = (PFptr); g.pf_pitch = (PFpitch); pg8::StaticOrder S; S.init(M, (Ncols), F.G, (int)blockIdx.x); \
        EPI E{__VA_ARGS__}; pg8::gemm_phase<EPI, pg8::StaticOrder, true, GEMM_SP2>(F.lds, g, S, E, F.w0); } while (0)
#define GEMM_PHASE(EPI, Aptr, Wptr, Ncols, Kdim, ...) do { pg8::Gemm g{(const bf16*)(Aptr), (const bf16*)(Wptr), M, (Ncols), (Kdim)}; pg8::StaticOrder S; S.init(M, (Ncols), F.G, (int)blockIdx.x); \
        EPI E{__VA_ARGS__}; pg8::gemm_phase<EPI, pg8::StaticOrder, true, GEMM_SP2>(F.lds, g, S, E, F.w0); } while (0)
template <int L> __device__ __forceinline__ void layer_phases(Frame& F, const Args& args, unsigned char* ws_, const XcdBarrier& bar, GroupBar& gb, unsigned* tmo_, const int pm_own, const int mem_own, const int lo, const int hi) {
    const int nrow_lo = pm_own * 256 + mem_own * 64, nrow_hi = nrow_lo + 64;
    const int ru_first = (pm_own * 2) * 4 + mem_own;
    constexpr int P0 = L * PH_PER_LAYER;
    const float* x_in = (const float*)args.in[0]; float* xres = args.out;
#define X0 (L > 0 ? (const void*)xres : (const void*)x_in)
#define MODL(LL, i) ((const float*)(ws + WS_MOD) + (size_t)(LL) * 2 * NMOD + (i) * D)
#define MODP(i) MODL(L, i)
#define SSP(LL, j) ((float*)(ws + WS_SS) + (size_t)((LL) * 3 + (j)) * M)
#define TPP(LL, j) ((float*)(ws + WS_T) + (size_t)((LL) * 3 + (j)) * 2 * T_LD)
#define LAYERW(W, LL, WITH_T) LayerW W; W.up1 = (const float*)args.in[9] + (size_t)(LL) * D * NUP; W.dn1 = (const float*)args.in[10] + (size_t)(LL) * FF * D; W.up2 = (const float*)args.in[11] + (size_t)(LL) * D * NUP; \
        W.dn2 = (const float*)args.in[12] + (size_t)(LL) * FF * D; W.win = (const float*)args.in[13] + (size_t)(LL) * D * NIN; W.wbr = (const float*)args.in[15] + (size_t)(LL) * D * D; \
        W.wbs = (const float*)args.in[16] + (size_t)(LL) * D * D; W.wout = (const float*)args.in[17] + (size_t)(LL) * D * D; W.T = (WITH_T) ? TPP(LL, 0) : nullptr; W.mod = MODL(LL, 0); W.t_up1 = (LL) == 1;
#define TAIL_CONV(LL, first, last, nunits) TAIL_CONV_(false, LL, first, last, nunits)
#define TAIL_CONV_(WTH, LL, first, last, nunits) do { const int busy_ = (nunits) % F.G; if (busy_ != 0 && (int)blockIdx.x >= busy_) { LAYERW(Wt_, LL, true) \
        { const int t_ = F.w0 * 64 + xb_lane_id(); F.tid = t_; F.lane = t_ & 63; F.wave = F.w0; } \
        conv_items<WTH>(F, Wt_, ws, (first), (last), ((int)blockIdx.x - busy_) * NWAVES + F.wave, (F.G - busy_) * NWAVES); } } while (0)
#define CONV_DONE(LL, nunits) do { const int busy_ = (nunits) % F.G; if (!(PROBE_GB & 4) && busy_ != 0 && (int)blockIdx.x >= busy_) { asm volatile("s_waitcnt vmcnt(0)" ::: "memory"); __syncthreads(); \
        if (F.w0 == 0 && xb_lane_id() == 0) (void)xb_add((unsigned*)(ws_ + WS_CTL) + CW_CNV + 64 * (LL), 1u); } } while (0)
#define PHASE_PASSED(idx) do { asm volatile("s_waitcnt vmcnt(0)" ::: "memory"); __syncthreads(); if (F.w0 == 0 && xb_lane_id() == 0) (void)xb_add((unsigned*)(ws_ + WS_CTL) + CW_CNV + 64 * (idx), 1u); } while (0)
#define PASSED_WAIT(idx, nunits) do { const int busy_ = (nunits) % F.G; if (hi - lo > 1 && busy_ != 0 && (int)blockIdx.x >= busy_) { if (F.w0 == 0 && xb_lane_id() == 0) { unsigned sp_ = 0u; \
        while (xb_ld((unsigned*)(ws_ + WS_CTL) + CW_CNV + 64 * (idx)) < (unsigned)F.G) { __builtin_amdgcn_s_sleep(1); if ((++sp_ & 255u) == 0u) { if (xb_ld(tmo_)) break; if (sp_ > XB_SPIN_CAP) { atomicAdd(tmo_, 1u); break; } } } } \
        __syncthreads(); } } while (0)
#define PH_END_SEL_CW(k, cw, LL, nunits) if (rep_ > 0) xcd_barrier(bar); else if ((k) + 1 < hi) { if (USE_GROUP_BAR) { const int busy_ = (nunits) % F.G; \
        group_barrier(gb, tmo_, ((cw) && busy_ != 0) ? (unsigned*)(ws_ + WS_CTL) + CW_CNV + 64 * (LL) : (unsigned*)nullptr, (unsigned)(F.G - busy_)); } else xcd_barrier(bar); } } }
#define PH_END_GROUP_NBR(k) if (rep_ > 0) xcd_barrier(bar); else if ((k) + 1 < hi) { if (USE_GROUP_BAR) group_barrier(gb, tmo_, nullptr, 0u, (pm_own & 31) != 0 ? (unsigned*)(ws_ + WS_CTL) + CW_GRP + 64 * (pm_own - 1) : (unsigned*)nullptr, true); else xcd_barrier(bar); } } }
#define PH_END_GROUP_CW(k, LL, nunits) if (rep_ > 0) xcd_barrier(bar); else if ((k) + 1 < hi) { if (USE_GROUP_BAR) { const int busy_ = (nunits) % F.G; \
        group_barrier(gb, tmo_, (!(PROBE_GB & 4) && busy_ != 0) ? (unsigned*)(ws_ + WS_CTL) + CW_CNV + 64 * (LL) : (unsigned*)nullptr, (unsigned)(F.G - busy_)); } else xcd_barrier(bar); } } }
    if (L == 0) {
    PH_BEGIN(P0 + 0)
        LAYERW(W, 0, false)
        { GAS f32x4* z = (GAS f32x4*)(ws + WS_SS); for (int i = F.vcu * NTHREADS + F.tid; i < (int)(ZERO_BYTES / 16); i += F.G * NTHREADS) z[i] = (f32x4){0.f, 0.f, 0.f, 0.f}; }
        mod_rope_phase(F, (const float*)args.in[1], (const float*)args.in[7], (const float*)args.in[8], (const int*)args.in[2], ws);
        conv_items<WT_A0>(F, W, ws, CV_A0, CV_A1, F.vcu * NWAVES + F.wave, F.G * NWAVES);
    PH_END(P0 + 0)
    if (lo <= 0 && 1 < hi) {
        unsigned id0 = 0u, same = 1u;
        for (int j = 0; j < 4; ++j) { const unsigned v = xb_ld((unsigned*)(ws_ + WS_CTL) + CW_XID + ((pm_own >> 3) + 8 * (pm_own & 7) + 64 * j)); if (j == 0) id0 = v; same &= (v == id0 && v != 0u) ? 1u : 0u; }
        gb.same_xcd = same;
        unsigned nsame = same; if ((pm_own & 31) != 31) { const int q = pm_own + 1; for (int j = 0; j < 4; ++j) { const unsigned v = xb_ld((unsigned*)(ws_ + WS_CTL) + CW_XID + ((q >> 3) + 8 * (q & 7) + 64 * j)); nsame &= (v == id0 && v != 0u) ? 1u : 0u; } }
        gb.next_same = nsame;
    }
    PH_BEGIN(P0 + 1) norm_phase(F, x_in, (const float*)args.in[3], MODP(0), MODP(1), (bf16*)(ws + WS_XN), nrow_lo, nrow_hi); PH_END_GROUP(P0 + 1)
    }
    PH_BEGIN(P0 + 2) { GEMM_PHASE(pg8::EpiSwiGLU, ws + WS_XN, ws + WS_WUP1, NUP, D, (bf16*)(ws + WS_H), FF, L == 0 ? (const float*)nullptr : (const float*)SSP(0, 2), (const float*)TPP(1, 0)); if (!dry) { if (L == 1) PASSED_WAIT(3, (M / 256) * (NUP / 256)); TAIL_CONV_(true, L, CV_B0, CV_B1, (M / 256) * (NUP / 256)); CONV_DONE(L, (M / 256) * (NUP / 256)); } } PH_END_GROUP(P0 + 2)
    PH_BEGIN(P0 + 3) GEMM_PHASE_PFS(pg8::EpiRes<!DBG_REP COMMA_ (L == 0)>, ws + WS_H, ws + WS_WDN1, D, FF, (const void*)xres, 4096, (const void*)X0, (_Float16*)xres, MODP(2), NMOD, COEF_(0.5f), XBSEL_((bf16*)(ws + WS_XN)), (const float*)args.in[4] + L * D, MODP(4), SSP(L, 0)); PH_END_GROUP_CW(P0 + 3, L, (M / 256) * (NUP / 256))
    PH_BEGIN(P0 + 5) { GEMM_PHASE(pg8::EpiProj, ws + WS_XN, ws + WS_WIN, NIN, D, (bf16*)(ws + WS_RQ), (bf16*)(ws + WS_RK), (bf16*)(ws + WS_RV), (bf16*)(ws + WS_RG), (bf16*)(ws + WS_SQ), (bf16*)(ws + WS_SK), (bf16*)(ws + WS_SV),
            (bf16*)(ws + WS_GR), (bf16*)(ws + WS_GS), (const float*)(ws + WS_COSR), (const float*)(ws + WS_SINR), (const float*)(ws + WS_COSS), (const float*)(ws + WS_SINS), (const float*)SSP(L, 0), (const float*)TPP(L, 1)); if (!dry) { if (L == 1) PASSED_WAIT(4, (M / 256) * (NIN / 256)); TAIL_CONV_(WT_C, L, CV_C0, CV_C1, (M / 256) * (NIN / 256)); } } PH_END_GROUP_NBR(P0 + 5)
    PH_BEGIN(P0 + 6) {
        kv_phase(F, (const bf16*)(ws + WS_RK), (const bf16*)(ws + WS_RV), (bf16*)(ws + WS_KV), ru_first, 4, ru_first + 8);
        { const int u = 4 * pm_own + mem_own; swa_unit(F, u, (bf16*)(ws + WS_SQ), dry ? (bf16*)(ws + WS_H) : (bf16*)(ws + WS_SQ), (const bf16*)(ws + WS_SK), (const bf16*)(ws + WS_SV), (const float*)args.in[14] + L * 16); } }
    PH_END(P0 + 6)
    PH_BEGIN(P0 + 7) if (!dry) scan_phase(F, (bf16*)(ws + WS_KV)); PH_END(P0 + 7)
    PH_BEGIN(P0 + 8) ret_phase(F, (const bf16*)(ws + WS_RQ), (const bf16*)(ws + WS_RK), (const bf16*)(ws + WS_RV), (bf16*)(ws + WS_RV), (const bf16*)(ws + WS_RG), (const bf16*)(ws + WS_KV), ru_first, 4, ru_first + 8); PH_END_GROUP(P0 + 8)
    PH_BEGIN(P0 + 9) { pg8::Gemm g{(const bf16*)(ws + WS_RV), (const bf16*)(ws + WS_WBR), M, D, 2 * D, D, (const bf16*)(ws + WS_SQ)}; g.a_tile = pg8::PSTR * 2; g.pf = (const void*)(ws + WS_GS); g.pf_pitch = 2048; pg8::StaticOrder S; S.init(M, D, F.G, (int)blockIdx.x);
        pg8::EpiMergeCat E{(const bf16*)(ws + WS_GR), (const bf16*)(ws + WS_GS), (bf16*)(ws + WS_MG)}; pg8::gemm_phase<pg8::EpiMergeCat, pg8::StaticOrder, true, true>(F.lds, g, S, E, F.w0); } PH_END_GROUP(P0 + 9)
    PH_BEGIN(P0 + 11) GEMM_PHASE_PF(pg8::EpiRes<!DBG_REP COMMA_ false>, ws + WS_MG, ws + WS_WOUT, D, D, (const void*)xres, 4096, (const void*)xres, (_Float16*)xres, MODP(5), NMOD, COEF_(1.0f), XBSEL_((bf16*)(ws + WS_XN)), (const float*)args.in[5] + L * D, MODP(7), SSP(L, 1)); if (L == 0 && hi - lo > 1) PHASE_PASSED(3); PH_END_GROUP(P0 + 11)
    PH_BEGIN(P0 + 13) { GEMM_PHASE(pg8::EpiSwiGLU, ws + WS_XN, ws + WS_WUP2, NUP, D, (bf16*)(ws + WS_H), FF, (const float*)SSP(L, 1), (const float*)TPP(L, 2)); if (L == 0 && !dry) { TAIL_CONV_(true, 1, CV_A0, CV_A1, (M / 256) * (NUP / 256)); CONV_DONE(2, (M / 256) * (NUP / 256)); } } PH_END_GROUP(P0 + 13)
    PH_BEGIN(P0 + 14) GEMM_PHASE_PFS(pg8::EpiRes<(L == 0) && !DBG_REP COMMA_ false>, ws + WS_H, ws + WS_WDN2, D, FF, (const void*)xres, 4096, (const void*)xres, (_Float16*)xres, MODP(8), NMOD, COEF_(0.5f), (L == 0) ? XBSEL_((bf16*)(ws + WS_XN)) : (bf16*)nullptr, (const float*)args.in[3] + 1 * D, MODL(1, 1), SSP(0, 2)); if (L == 0 && hi - lo > 1) PHASE_PASSED(4); PH_END_SEL_CW(P0 + 14, L == 0, 2, (M / 256) * (NUP / 256))
#undef X0
#undef MODP
}
__global__ void __launch_bounds__(NTHREADS, 2) fwd_kernel(Args args) {
    extern __shared__ __attribute__((aligned(16))) unsigned char lds_raw[];
    Frame F;
    F.lds = (LAS unsigned char*)lds_raw;
    F.tid = threadIdx.x; F.lane = F.tid & 63; F.wave = __builtin_amdgcn_readfirstlane(F.tid >> 6);
    { int w0_ = F.wave; asm volatile("" : "+s"(w0_)); F.w0 = w0_; }
    F.G = gridDim.x; { const int bx = blockIdx.x; F.vcu = (F.G % 8 == 0) ? (bx % 8) * (F.G / 8) + bx / 8 : bx; }
    unsigned char* ws_ = args.ws;
    volatile LAS unsigned* MISC = (volatile LAS unsigned*)(F.lds + MISC_OFF);
    if (F.tid < 32) MISC[F.tid] = 0u;
    __syncthreads();
    const int lo = args.ph_lo, hi = args.ph_hi;
    XcdBarrier bar; bar.bar = (unsigned*)(ws_ + WS_CTL) + CW_BAR; bar.x = 0; bar.st = MISC + 8;
    if (hi - lo > 1) bar = xcd_barrier_post((unsigned*)(ws_ + WS_CTL) + CW_BAR, MISC + 8);
    bar.w0 = (unsigned)F.w0;

    const int pm_own = 8 * ((int)blockIdx.x & 7) + (((int)blockIdx.x >> 3) & 7), mem_own = (int)blockIdx.x >> 6;
    GroupBar gb; gb.cnt = (unsigned*)(ws_ + WS_CTL) + CW_GRP + 64 * pm_own; gb.epoch = 0u; gb.same_xcd = 0u; gb.next_same = 0u; gb.w0 = (unsigned)F.w0;
    unsigned* tmo_ = (unsigned*)(ws_ + WS_CTL) + CW_BAR + XB_TMO;
    if (threadIdx.x == 0) __hip_atomic_store((unsigned*)(ws_ + WS_CTL) + CW_XID + blockIdx.x, xb_xcc_id() + 1u, __ATOMIC_RELAXED, __HIP_MEMORY_SCOPE_AGENT);
    layer_phases<0>(F, args, ws_, bar, gb, tmo_, pm_own, mem_own, lo, hi);
    layer_phases<1>(F, args, ws_, bar, gb, tmo_, pm_own, mem_own, lo, hi);
    const int nrow_lo = pm_own * 256 + mem_own * 64, nrow_hi = nrow_lo + 64;
    PH_BEGIN(30)
        if (EN_FFN1 || EN_MIX || EN_FFN2) final_norm_phase(F, args.out, (const float*)args.in[6], nrow_lo, nrow_hi);
        else { const float* x_in = (const float*)args.in[0]; const int gw = F.vcu * NWAVES + F.wave, NGW = F.G * NWAVES;
            for (int m = gw; m < M; m += NGW) { const GAS f32x4* xr = (const GAS f32x4*)(x_in + (size_t)m * D) + F.lane; GAS f32x4* orow = (GAS f32x4*)(args.out + (size_t)m * D) + F.lane;
                f32x4 v[4]; float ss = 0.f;
                for (int j = 0; j < 4; ++j) { v[j] = xr[64 * j]; ss += (v[j].x * v[j].x + v[j].y * v[j].y) + (v[j].z * v[j].z + v[j].w * v[j].w); }
                const float rstd = 1.0f / sqrtf(wave_sum(ss) * (1.0f / D) + NORM_EPS);
                for (int j = 0; j < 4; ++j) orow[64 * j] = (v[j] * rstd) * ((const GAS f32x4*)args.in[6])[F.lane + 64 * j]; } }
    PH_END(30)
}

extern "C" void kernel_launch(void* const* d_in, const int* in_sizes, int n_in, void* d_out, int out_size, void* d_ws, size_t ws_size, hipStream_t stream) {
    static int grid = 0;
    if (grid == 0) {
        if (n_in != 18 || in_sizes[0] != M * D || out_size != M * D || ws_size < WS_END) { fprintf(stderr, "kernel_launch: unexpected problem (n_in %d, in0 %d, out %d, ws %zu < %zu); nothing launched\n", n_in, n_in > 0 ? in_sizes[0] : -1, out_size, ws_size, (size_t)WS_END); grid = -1; return; }
        int dev = 0, cus = 0, per_cu = 0;
        if (hipGetDevice(&dev) != hipSuccess || hipDeviceGetAttribute(&cus, hipDeviceAttributeMultiprocessorCount, dev) != hipSuccess) { grid = -1; return; }
        if (hipFuncSetAttribute((const void*)fwd_kernel, hipFuncAttributeMaxDynamicSharedMemorySize, LDS_BYTES) != hipSuccess) { fprintf(stderr, "kernel_launch: hipFuncSetAttribute failed\n"); grid = -1; return; }
        if (hipOccupancyMaxActiveBlocksPerMultiprocessor(&per_cu, (const void*)fwd_kernel, NTHREADS, LDS_BYTES) != hipSuccess || per_cu < 1) fprintf(stderr, "kernel_launch: occupancy query says %d\n", per_cu);
        (void)hipGetLastError();
        grid = cus;
        if (grid != 256) { fprintf(stderr, "kernel_launch: this kernel's panel ownership needs exactly 256 workgroups (CUs), device has %d; nothing launched\n", cus); grid = -1; return; }
    }
    if (grid < 0) return;
#ifdef DBG_MEMSET_ALL
    (void)hipMemsetAsync((char*)d_ws, 0x11, WS_END, stream); (void)hipMemsetAsync(d_out, 0x11, (size_t)M * D * 4, stream);
#endif
    if (hipMemsetAsync((char*)d_ws + WS_CTL, 0, CTL_ZERO_BYTES, stream) != hipSuccess) { fprintf(stderr, "kernel_launch: memset failed\n"); return; }
    Args a{};
    for (int i = 0; i < 18; ++i) a.in[i] = d_in[i];
    a.out = (float*)d_out; a.ws = (unsigned char*)d_ws;
#if MK_ONE_LAUNCH
    a.ph_lo = 0; a.ph_hi = N_PHASES;
    hipLaunchKernelGGL(fwd_kernel, dim3(grid), dim3(NTHREADS), LDS_BYTES, stream, a);
#else
    for (int ph = 0; ph < N_PHASES; ++ph) { a.ph_lo = ph; a.ph_hi = ph + 1; hipLaunchKernelGGL(fwd_kernel, dim3(grid), dim3(NTHREADS), LDS_BYTES, stream, a); }
#endif
}
```

```cpp
#include <hip/hip_runtime.h>
#include <cstdio>
#include <cstdint>
namespace pg8 {
#define PG8_LAS __attribute__((address_space(3)))
typedef unsigned short bf16_t;
typedef short bf16x8 __attribute__((ext_vector_type(8)));
typedef float f32x4 __attribute__((ext_vector_type(4)));
typedef unsigned u32x4 __attribute__((ext_vector_type(4)));
constexpr size_t PSTR = 786432;
__host__ __device__ __forceinline__ size_t prow(size_t row) { return (row >> 8) * PSTR + (row & 255) * 1024; }
constexpr int BM = 256, BK = 64, HALF = 128, HTB = HALF * BK * 2  , STAGE_BYTES = 8 * HTB, NXCD = 8, WGM = 8;

__host__ __device__ __forceinline__ int lds_byte(int r, int c) { const int st = (r >> 4) * 2 + (c >> 5), rr = r & 15, cc = c & 31, ob = rr * 64 + cc * 2; return st * 1024 + (ob ^ (((ob >> 9) & 1) << 5)); }
__host__ __device__ __forceinline__ void stage_rc(int b, int& R, int& C) { const int st = b / 1024, sb = b % 1024, swz = sb ^ (((sb >> 9) & 1) << 5); R = (st >> 1) * 16 + swz / 64; C = (st & 1) * 32 + (swz % 64) / 2; }
__host__ __device__ __forceinline__ int perm32(int rho) { const int n = rho >> 4, i = rho & 15; return 8 * (i >> 2) + 4 * n + (i & 3); }

struct Unit { int pm, pn; };
struct Gemm { const bf16_t* A; const bf16_t* Bt; int M, N, K; int lda = 0; const bf16_t* A2 = nullptr; const void* pf = nullptr; int pf_pitch = 0; size_t a_tile = 0;   };

struct StaticOrder {
    int nM, nN, nwg, G, c;
    __host__ __device__ void init(int M, int N, int G_, int c_) { nM = M / BM; nN = N / BM; nwg = nM * nN; G = G_; c = c_; }
    __host__ __device__ bool next(int i, Unit& u) const {
        const long L = (long)i * G + c; if (L >= nwg) return false;
        int wgid = (int)L; { const int q = nwg / NXCD, r = nwg % NXCD, xcd = wgid % NXCD, off = wgid / NXCD; wgid = (xcd < r ? xcd * (q + 1) : r * (q + 1) + (xcd - r) * q) + off; }
        const int nig = WGM * nN, gid = wgid / nig, fm = gid * WGM, gsz = (nM - fm) < WGM ? (nM - fm) : WGM;
        u.pm = fm + ((wgid % nig) % gsz); u.pn = (wgid % nig) / gsz; return true;
    }
    __device__ __forceinline__ void a_ready(const Unit&) const {}
    __device__ __forceinline__ void done(const Unit&) const {}
};

template <class Epi, class Sched, bool ALIGN_EPI = false, bool SP2 = false>
__device__ __forceinline__ void gemm_phase(PG8_LAS unsigned char* lds, const Gemm g, const Sched& S, const Epi& E, const int w0) {
    int tid_; asm volatile("v_mbcnt_lo_u32_b32 %0, -1, 0\n\tv_mbcnt_hi_u32_b32 %0, -1, %0" : "=v"(tid_)); tid_ += w0 * 64;
    const int tid = tid_, wid = __builtin_amdgcn_readfirstlane(tid >> 6), lane = tid & 63, wr = wid >> 2, wc = wid & 3, fr = lane & 15, fq = lane >> 4;
    const int K = g.K, nt = K / BK;
    unsigned voffA[2], voffB[2];
#pragma unroll
    for (int i = 0; i < 2; ++i) { int R, C; stage_rc(tid * 16 + i * 8192, R, C); const int Rb = Epi::PERM ? ((R & ~31) + perm32(R & 31)) : R;
        voffA[i] = (unsigned)(R * (g.lda ? g.lda : K) + C) * 2u; voffB[i] = (unsigned)(Rb * K + C) * 2u; }
    asm volatile("" : "+v"(voffA[0]), "+v"(voffA[1]), "+v"(voffB[0]), "+v"(voffB[1]));
    const size_t kstep = (size_t)(BK * 2);
    const size_t hstep = (size_t)HALF * K * 2;
    const size_t tstep = 2 * hstep;
    const int lda = g.lda ? g.lda : K; const size_t hstepA = (size_t)HALF * lda * 2, tstepA = g.a_tile ? g.a_tile : 2 * hstepA; const int ntA = nt / 2;
    const unsigned ldsw = (unsigned)wid * 1024u;
    const int aoff = lds_byte(wr * 64 + fr, fq * 8), boff = lds_byte(wc * 32 + fr, fq * 8);
#define PG8_SA(b, h) (((b) * 2 + (h)) * HTB)
#define PG8_SB(b, h) ((4 + (b) * 2 + (h)) * HTB)
#define PG8_STAGE(bufoff, gbase, voff) do { _Pragma("unroll") for (int _i = 0; _i < 2; ++_i) \
        __builtin_amdgcn_global_load_lds((const unsigned*)((const char*)(gbase) + (voff)[_i]), (PG8_LAS unsigned*)(lds + (bufoff) + ldsw + _i * 8192), 16, 0, 0); } while (0)
#define PG8_STAGE2(bufoff, gbase, o0, o1) do { __builtin_amdgcn_global_load_lds((const unsigned*)((const char*)(gbase) + (o0)), (PG8_LAS unsigned*)(lds + (bufoff) + ldsw), 16, 0, 0); \
        __builtin_amdgcn_global_load_lds((const unsigned*)((const char*)(gbase) + (o1)), (PG8_LAS unsigned*)(lds + (bufoff) + ldsw + 8192), 16, 0, 0); } while (0)
#define PG8_LDA(dst, b, h) do { _Pragma("unroll") for (int m = 0; m < 4; ++m) _Pragma("unroll") for (int k = 0; k < 2; ++k) dst[m][k] = *(const PG8_LAS bf16x8*)(lds + PG8_SA(b, h) + aoff + m * 2048 + k * 1024); } while (0)
#define PG8_LDB(dst, b, h) do { _Pragma("unroll") for (int n = 0; n < 2; ++n) _Pragma("unroll") for (int k = 0; k < 2; ++k) dst[n][k] = *(const PG8_LAS bf16x8*)(lds + PG8_SB(b, h) + boff + n * 2048 + k * 1024); } while (0)
#define PG8_MMA(ai, bj, At, Bt) do { __builtin_amdgcn_s_setprio(1); _Pragma("unroll") for (int m = 0; m < 4; ++m) _Pragma("unroll") for (int n = 0; n < 2; ++n) _Pragma("unroll") for (int k = 0; k < 2; ++k) \
        acc[ai][bj][m][n] = __builtin_amdgcn_mfma_f32_16x16x32_bf16(Bt[n][k], At[m][k], acc[ai][bj][m][n], 0, 0, 0); __builtin_amdgcn_s_setprio(0); } while (0)
#define PG8_WAIT_V_(n) asm volatile("s_waitcnt vmcnt(" #n ")" ::: "memory")
#define PG8_WAIT_V(n) PG8_WAIT_V_(n)
#define PG8_WAIT_L(n) asm volatile("s_waitcnt lgkmcnt(" #n ")" ::: "memory")
#define PG8_BAR __builtin_amdgcn_s_barrier()
#define PG8_WAIT_VD(n) do { if (dfl_) PG8_WAIT_V(n); else PG8_WAIT_V(8); } while (0)
#define PG8_WAIT_VE() do { if (dfl_) { if constexpr (Epi::ND == 4) PG8_WAIT_V(10); else PG8_WAIT_V(9); } else PG8_WAIT_V(8); } while (0)
#define PG8_DST(j) do { const u32x4 v_ = *(const PG8_LAS u32x4*)(dlds + (j) * 8192); E.dstore((j), v_, prv, wr, wc, fr, fq); } while (0)
#define PG8_ITER_SP2(WVA, WVB, LASTEXPR, DSA, DSB) do { \
            const bool last = (LASTEXPR); \
            if constexpr (Epi::HAS_MID) { if (t == ntA) E.mid(acc, cur, wr, wc, fr, fq); } \
            const char* a1 = PG8_AP(t + 1); \
            const char* a2 = last ? nA : PG8_AP(t + 2); const char* b2 = last ? nB : cB + (size_t)(t + 2) * kstep; \
            const char* a3 = a2 + kstep; const char* b3 = b2 + kstep; \
            if (last && has_next) S.a_ready(nxt); \
            bool pf_ = false; if constexpr (Epi::PF) pf_ = last && !has_next && g.pf != nullptr; \
            const char* pfb_ = pf_ ? (const char*)g.pf + ((size_t)cur.pm * 256) * g.pf_pitch + (size_t)cur.pn * 512 : cB; const size_t pfs_ = (size_t)32 * g.pf_pitch; \
            const unsigned pfo0_ = (unsigned)((tid >> 5) * g.pf_pitch + (tid & 31) * 16), pfo1_ = pfo0_ + 16u * (unsigned)g.pf_pitch; \
            const unsigned vB0_ = pf_ ? pfo0_ : voffB[0], vB1_ = pf_ ? pfo1_ : voffB[1], vA0_ = pf_ ? pfo0_ : voffA[0], vA1_ = pf_ ? pfo1_ : voffA[1]; \
            DSA; \
            PG8_LDB(B0, 0, 0); PG8_LDB(B1, 0, 1); PG8_SCHED; PG8_LDA(At, 0, 0); PG8_STAGE(PG8_SA(1, 1), a1 + hstepA, voffA); \
            PG8_WAIT_VD(10); PG8_WAIT_L(0); PG8_BAR; PG8_MMA(0, 0, At, B0); PG8_MMA(0, 1, At, B1); PG8_BAR; PG8_SCHED; \
            PG8_LDA(At, 0, 1); PG8_STAGE2(PG8_SB(0, 0), pf_ ? pfb_ : b2, vB0_, vB1_); PG8_STAGE2(PG8_SB(0, 1), pf_ ? pfb_ + pfs_ : b2 + hstep, vB0_, vB1_); PG8_STAGE2(PG8_SA(0, 0), pf_ ? pfb_ + 2 * pfs_ : a2, vA0_, vA1_); \
            PG8_WAIT_VD(10); PG8_WAIT_L(0); PG8_BAR; PG8_MMA(1, 0, At, B0); PG8_MMA(1, 1, At, B1); PG8_BAR; PG8_SCHED; \
            DSB; \
            PG8_LDB(B0, 1, 0); PG8_LDB(B1, 1, 1); PG8_SCHED; PG8_LDA(At, 1, 0); PG8_STAGE2(PG8_SA(0, 1), pf_ ? pfb_ + 3 * pfs_ : a2 + hstepA, vA0_, vA1_); \
            PG8_WAIT_VE(); PG8_WAIT_L(0); PG8_BAR; PG8_MMA(0, 0, At, B0); PG8_MMA(0, 1, At, B1); PG8_BAR; PG8_SCHED; \
            PG8_LDA(At, 1, 1); PG8_STAGE2(PG8_SB(1, 0), pf_ ? pfb_ + 4 * pfs_ : b3, vB0_, vB1_); PG8_STAGE2(PG8_SB(1, 1), pf_ ? pfb_ + 5 * pfs_ : b3 + hstep, vB0_, vB1_); PG8_STAGE2(PG8_SA(1, 0), pf_ ? pfb_ + 6 * pfs_ : a3, vA0_, vA1_); \
            PG8_WAIT_VE(); PG8_WAIT_L(0); PG8_BAR; PG8_MMA(1, 0, At, B0); PG8_MMA(1, 1, At, B1); PG8_BAR; PG8_SCHED; \
        } while (0)
#define PG8_SCHED __builtin_amdgcn_sched_barrier(0)
    static_assert(SP2 || !Epi::HAS_MID, "the two-half A operand is wired into the SP2 loop only");
    Unit cur, nxt; int ui = 0;
    if (!S.next(0, cur)) return;
    f32x4 acc[2][2][4][2];
#pragma unroll
    for (int a = 0; a < 2; ++a)
#pragma unroll
        for (int b = 0; b < 2; ++b)
#pragma unroll
            for (int m = 0; m < 4; ++m)
#pragma unroll
                for (int n = 0; n < 2; ++n) acc[a][b][m][n] = (f32x4){0.f, 0.f, 0.f, 0.f};
    bf16x8 At[4][2], B0[2][2], B1[2][2];
    Unit prv = {0, 0}; bool pend = false; (void)prv; (void)pend;
    static_assert(Epi::ND == 0 || Epi::ND == 3 || Epi::ND == 4 || true, "deferred stores: one K-loop iteration, groups of 2 + 1 or 2 + 2");
    PG8_LAS unsigned char* const dlds = lds + STAGE_BYTES + tid * 16; (void)dlds;
    const char* cA = (const char*)g.A + (size_t)cur.pm * tstepA; const char* cB = (const char*)g.Bt + (size_t)cur.pn * tstep;
    const char* cA2 = cA; if constexpr (Epi::HAS_MID) cA2 = (const char*)g.A2 + (size_t)cur.pm * tstepA - (size_t)ntA * kstep;
#define PG8_AP(tile) (Epi::HAS_MID && (tile) >= ntA ? cA2 + (size_t)(tile) * kstep : cA + (size_t)(tile) * kstep)
    S.a_ready(cur);
    if constexpr (SP2) {
        PG8_STAGE(PG8_SB(0, 0), cB, voffB); PG8_STAGE(PG8_SB(0, 1), cB + hstep, voffB); PG8_STAGE(PG8_SA(0, 0), cA, voffA); PG8_STAGE(PG8_SA(0, 1), cA + hstepA, voffA);
        if (wr == 1) PG8_BAR;
        PG8_WAIT_V(2); PG8_BAR;
        PG8_STAGE(PG8_SB(1, 0), cB + kstep, voffB); PG8_STAGE(PG8_SA(1, 0), cA + kstep, voffA); PG8_STAGE(PG8_SB(1, 1), cB + hstep + kstep, voffB);
        PG8_WAIT_V(6); PG8_BAR;
    } else {
        PG8_STAGE(PG8_SB(0, 0), cB, voffB); PG8_STAGE(PG8_SA(0, 0), cA, voffA); PG8_STAGE(PG8_SB(0, 1), cB + hstep, voffB); PG8_STAGE(PG8_SA(0, 1), cA + hstep, voffA);
        if (wr == 1) PG8_BAR;
        PG8_WAIT_V(4); PG8_BAR;
        PG8_STAGE(PG8_SB(1, 0), cB + kstep, voffB); PG8_STAGE(PG8_SA(1, 0), cA + kstep, voffA); PG8_STAGE(PG8_SB(1, 1), cB + hstep + kstep, voffB);
        PG8_WAIT_V(6); PG8_BAR;
    }
    for (;;) {
        const bool has_next = S.next(ui + 1, nxt);
        const char* nA = has_next ? (const char*)g.A + (size_t)nxt.pm * tstepA : cA; const char* nB = has_next ? (const char*)g.Bt + (size_t)nxt.pn * tstep : cB;
        int t = 0;
        if constexpr (SP2) {
            for (; t < nt; t += 2) {
                bool dfl_ = false; if constexpr (Epi::ND > 0) dfl_ = pend && t == 0;
                PG8_ITER_SP2(A, B, t == nt - 2, do { if constexpr (Epi::ND > 0) { if (dfl_) { PG8_DST(0); PG8_DST(1); } } } while (0), do { if constexpr (Epi::ND > 0) { if (dfl_) { PG8_DST(2); if constexpr (Epi::ND == 4) PG8_DST(3); } } } while (0));
            }
        } else {
        for (; t < nt; t += 2) {
            const bool last = (t == nt - 2);
            if constexpr (Epi::HAS_MID) { if (t == ntA) E.mid(acc, cur, wr, wc, fr, fq); }
            const char* a1 = PG8_AP(t + 1);
            const char* a2 = last ? nA : PG8_AP(t + 2); const char* b2 = last ? nB : cB + (size_t)(t + 2) * kstep;
            const char* a3 = a2 + kstep; const char* b3 = b2 + kstep;
            if (last && has_next) S.a_ready(nxt);
            bool pf_ = false; if constexpr (Epi::PF) pf_ = last && !has_next && g.pf != nullptr;
            const char* pfb_ = pf_ ? (const char*)g.pf + ((size_t)cur.pm * 256) * g.pf_pitch + (size_t)cur.pn * 512 : cB; const size_t pfs_ = (size_t)32 * g.pf_pitch;
            const unsigned pfo0_ = (unsigned)((tid >> 5) * g.pf_pitch + (tid & 31) * 16), pfo1_ = pfo0_ + 16u * (unsigned)g.pf_pitch;
            const unsigned vB0_ = pf_ ? pfo0_ : voffB[0], vB1_ = pf_ ? pfo1_ : voffB[1], vA0_ = pf_ ? pfo0_ : voffA[0], vA1_ = pf_ ? pfo1_ : voffA[1];
            PG8_LDB(B0, 0, 0); PG8_SCHED; PG8_LDA(At, 0, 0); PG8_STAGE(PG8_SA(1, 1), a1 + hstep, voffA);
            PG8_WAIT_L(8); PG8_BAR; PG8_WAIT_L(0); PG8_MMA(0, 0, At, B0); PG8_BAR; PG8_SCHED;
            PG8_LDB(B1, 0, 1); PG8_STAGE(PG8_SB(0, 0), b2, voffB);
            PG8_BAR; PG8_WAIT_L(0); PG8_MMA(0, 1, At, B1); PG8_BAR;
            PG8_LDA(At, 0, 1); PG8_STAGE(PG8_SA(0, 0), a2, voffA);
            PG8_BAR; PG8_WAIT_L(0); PG8_MMA(1, 0, At, B0); PG8_BAR; PG8_SCHED;
            PG8_STAGE(PG8_SB(0, 1), b2 + hstep, voffB);
            PG8_WAIT_V(6); PG8_BAR; PG8_MMA(1, 1, At, B1); PG8_BAR;
            PG8_LDB(B0, 1, 0); PG8_SCHED; PG8_LDA(At, 1, 0); PG8_STAGE(PG8_SA(0, 1), a2 + hstep, voffA);
            PG8_WAIT_L(8); PG8_BAR; PG8_WAIT_L(0); PG8_MMA(0, 0, At, B0); PG8_BAR; PG8_SCHED;
            PG8_LDB(B1, 1, 1); PG8_STAGE(PG8_SB(1, 0), b3, voffB);
            PG8_BAR; PG8_WAIT_L(0); PG8_MMA(0, 1, At, B1); PG8_BAR;
            PG8_LDA(At, 1, 1); PG8_STAGE(PG8_SA(1, 0), a3, voffA);
            PG8_BAR; PG8_WAIT_L(0); PG8_MMA(1, 0, At, B0); PG8_BAR; PG8_SCHED;
            PG8_STAGE(PG8_SB(1, 1), b3 + hstep, voffB);
            PG8_WAIT_V(6); PG8_BAR; PG8_MMA(1, 1, At, B1); PG8_BAR;
            }
        }
        if constexpr (ALIGN_EPI) { if (wr == 0) PG8_BAR; }
        int fr_e, fq_e; { int l_; asm volatile("v_mbcnt_lo_u32_b32 %0, -1, 0\n\tv_mbcnt_hi_u32_b32 %0, -1, %0" : "=v"(l_)); fr_e = l_ & 15; fq_e = l_ >> 4; }
        if constexpr (Epi::ND > 0) { static_assert(SP2 && !Epi::AFTER_DRAIN, "deferred stores are wired into the SP2 loop only");
            if (has_next) { E.template run<true>(acc, cur, wr, wc, fr_e, fq_e, dlds); prv = cur; pend = true; } else { E.template run<false>(acc, cur, wr, wc, fr_e, fq_e, dlds); pend = false; }
            S.done(cur); }
        else if constexpr (!Epi::AFTER_DRAIN) { E(acc, cur, wr, wc, fr_e, fq_e); S.done(cur); }
        if (!has_next) break;
#pragma unroll
        for (int a = 0; a < 2; ++a)
#pragma unroll
            for (int b = 0; b < 2; ++b)
#pragma unroll
                for (int m = 0; m < 4; ++m)
#pragma unroll
                    for (int n = 0; n < 2; ++n) acc[a][b][m][n] = (f32x4){0.f, 0.f, 0.f, 0.f};
        cur = nxt; cA = nA; cB = nB; ++ui; if constexpr (Epi::HAS_MID) cA2 = (const char*)g.A2 + (size_t)cur.pm * tstepA - (size_t)ntA * kstep;
        if constexpr (ALIGN_EPI) { if (wr == 1) PG8_BAR; }
    }
    PG8_WAIT_V(0);
    if constexpr (!ALIGN_EPI) { if (wr == 0) PG8_BAR; }
    PG8_BAR;
    if constexpr (Epi::AFTER_DRAIN) { E.fused(acc, cur, wr, wc, fr, fq, lds, wid, lane); S.done(cur); }
#undef PG8_AP
#undef PG8_STAGE2
#undef PG8_SA
#undef PG8_SB
#undef PG8_STAGE
#undef PG8_LDA
#undef PG8_LDB
#undef PG8_MMA
#undef PG8_WAIT_V
#undef PG8_WAIT_V_
#undef PG8_ITER_SP2
#undef PG8_DST
#undef PG8_WAIT_VD
#undef PG8_WAIT_VE
#undef PG8_WAIT_L
#undef PG8_BAR
#undef PG8_SCHED
}
}
namespace pg8 {
#define PG8_GAS __attribute__((address_space(1)))
typedef float f32x2_cv __attribute__((ext_vector_type(2))); typedef __bf16 bf16x2_cv __attribute__((ext_vector_type(2)));
__device__ __forceinline__ unsigned cvt_pk_bf16(float lo, float hi) { const f32x2_cv v = {lo, hi}; const bf16x2_cv b = __builtin_convertvector(v, bf16x2_cv); return __builtin_bit_cast(unsigned, b); }
__device__ __forceinline__ float fsigmoid(float x) { return __builtin_amdgcn_rcpf(1.0f + __builtin_amdgcn_exp2f(-1.4426950408889634f * x)); }
__device__ __forceinline__ float fsilu(float x) { return x * fsigmoid(x); }
__device__ __forceinline__ u32x4 pack8(const f32x4 a, const f32x4 b) { u32x4 w; w.x = cvt_pk_bf16(a[0], a[1]); w.y = cvt_pk_bf16(a[2], a[3]); w.z = cvt_pk_bf16(b[0], b[1]); w.w = cvt_pk_bf16(b[2], b[3]); return w; }
__device__ __forceinline__ void unpack8(const u32x4 w, f32x4& a, f32x4& b) {
    a[0] = __uint_as_float(w.x << 16); a[1] = __uint_as_float(w.x & 0xffff0000u); a[2] = __uint_as_float(w.y << 16); a[3] = __uint_as_float(w.y & 0xffff0000u);
    b[0] = __uint_as_float(w.z << 16); b[1] = __uint_as_float(w.z & 0xffff0000u); b[2] = __uint_as_float(w.w << 16); b[3] = __uint_as_float(w.w & 0xffff0000u); }

__device__ __forceinline__ void fold_apply(f32x4 (&acc)[2][2][4][2], const Unit& u, int wr, int wc, int fr, int fq, const float* SS, const float* T) {
    const int row0 = u.pm * BM + wr * 64 + fr, c0 = u.pn * BM + wc * 32 + 8 * fq;
    const float* Tb = T + (u.pm >= 32 ? 6400 : 0);
    f32x4 tv[2][2];
#pragma unroll
    for (int bj = 0; bj < 2; ++bj)
#pragma unroll
        for (int n = 0; n < 2; ++n) tv[bj][n] = *(const PG8_GAS f32x4*)(Tb + c0 + bj * HALF + 4 * n);
#pragma unroll
    for (int ai = 0; ai < 2; ++ai)
#pragma unroll
        for (int m = 0; m < 4; ++m) { const float ss = *(const PG8_GAS float*)(SS + row0 + ai * HALF + m * 16); const float r = __builtin_amdgcn_rsqf(ss * (1.0f / 1024.0f) + 1e-6f);
#pragma unroll
            for (int bj = 0; bj < 2; ++bj)
#pragma unroll
                for (int n = 0; n < 2; ++n) acc[ai][bj][m][n] = acc[ai][bj][m][n] * r + tv[bj][n]; }
}
#ifndef DEFER_UP
#define DEFER_UP 3
#endif
struct EpiSwiGLU {
    static constexpr bool PERM = true, AFTER_DRAIN = false, HAS_MID = false, PF = false, SLAB = false;
    static constexpr int ND = DEFER_UP;
    bf16_t* H; int ldh; const float* SS; const float* T;
    __device__ __forceinline__ void sstore(int j8, const u32x4& v, const Unit& u, int wr, int wc, int fr, int fq) const {
        const int lrow = wr * 64 + fr + (j8 >> 2) * HALF + (j8 & 3) * 16, col0 = u.pn * HALF + wc * 32 + 8 * fq;
        *(PG8_GAS u32x4*)(H + (size_t)u.pm * PSTR + (size_t)lrow * ldh + col0) = v;
    }
    __device__ __forceinline__ void dstore(int j, const u32x4& v, const Unit& u, int wr, int wc, int fr, int fq) const { sstore(j + (8 - ND), v, u, wr, wc, fr, fq); }
    template <bool DEFER> __device__ __forceinline__ void run(f32x4 (&acc)[2][2][4][2], const Unit& u, int wr, int wc, int fr, int fq, PG8_LAS unsigned char* dl) const {
        if (SS) fold_apply(acc, u, wr, wc, fr, fq, SS, T);
#pragma unroll
        for (int ai = 0; ai < 2; ++ai)
#pragma unroll
            for (int m = 0; m < 4; ++m) { f32x4 v0, v1;
#pragma unroll
                for (int e = 0; e < 4; ++e) { v0[e] = fsilu(acc[ai][0][m][0][e]) * acc[ai][1][m][0][e]; v1[e] = fsilu(acc[ai][0][m][1][e]) * acc[ai][1][m][1][e]; }
                const int j = ai * 4 + m - (8 - ND);
                if (DEFER && j >= 0) *(PG8_LAS u32x4*)(dl + j * 8192) = pack8(v0, v1); else sstore(ai * 4 + m, pack8(v0, v1), u, wr, wc, fr, fq); }
    }
    __device__ __forceinline__ void operator()(f32x4 (&acc)[2][2][4][2], const Unit& u, int wr, int wc, int fr, int fq) const { run<false>(acc, u, wr, wc, fr, fq, nullptr); }
};
typedef _Float16 f16x8_t __attribute__((ext_vector_type(8)));
typedef float f32x8_t __attribute__((ext_vector_type(8)));
constexpr int XP = 2048;
template <bool NEXT, bool INF32, bool SLAB_ = false> struct EpiRes {
    static constexpr bool PERM = true, AFTER_DRAIN = false, HAS_MID = false, PF = !INF32, SLAB = SLAB_; static constexpr int ND = 0;
    const void* xin; _Float16* xout; const float* gate; int gstride; float coef;
    bf16_t* XB; const float* gainN; const float* scN; float* SSo;
    __device__ __forceinline__ void operator()(f32x4 (&acc)[2][2][4][2], const Unit& u, int wr, int wc, int fr, int fq) const {
        const int row0 = u.pm * BM + wr * 64 + fr, col0 = u.pn * BM + wc * 32 + 8 * fq, bo = (u.pm >= 32 ? gstride : 0);
        const float* g = gate + bo;
        f32x4 gv[2][2], wv[2][2];
#pragma unroll
        for (int bj = 0; bj < 2; ++bj)
#pragma unroll
            for (int n = 0; n < 2; ++n) { gv[bj][n] = *(const PG8_GAS f32x4*)(g + col0 + bj * HALF + n * 4) * coef;
                if (NEXT) wv[bj][n] = *(const PG8_GAS f32x4*)(gainN + col0 + bj * HALF + n * 4) * (*(const PG8_GAS f32x4*)(scN + bo + col0 + bj * HALF + n * 4) + 1.0f); }
#pragma unroll
        for (int ai = 0; ai < 2; ++ai)
#pragma unroll
            for (int m = 0; m < 4; ++m) { const int row = row0 + ai * HALF + m * 16; float ssum = 0.f;
#pragma unroll
                for (int bj = 0; bj < 2; ++bj) { f32x4 xn[2]; const int col = col0 + bj * HALF;
                    if (INF32) { const float* xf = (const float*)xin + (size_t)row * 1024 + col; xn[0] = __builtin_nontemporal_load((const PG8_GAS f32x4*)xf); xn[1] = __builtin_nontemporal_load((const PG8_GAS f32x4*)(xf + 4)); }
                    else { const f16x8_t hv = *(const PG8_GAS f16x8_t*)((const _Float16*)xin + (size_t)row * XP + col); const f32x8_t fv = __builtin_convertvector(hv, f32x8_t);
                        xn[0] = (f32x4){fv[0], fv[1], fv[2], fv[3]}; xn[1] = (f32x4){fv[4], fv[5], fv[6], fv[7]}; }
                    xn[0] += gv[bj][0] * acc[ai][bj][m][0]; xn[1] += gv[bj][1] * acc[ai][bj][m][1];
                    { const f32x8_t ov = {xn[0][0], xn[0][1], xn[0][2], xn[0][3], xn[1][0], xn[1][1], xn[1][2], xn[1][3]}; *(PG8_GAS f16x8_t*)(xout + (size_t)row * XP + col) = __builtin_convertvector(ov, f16x8_t); }
                    if (NEXT) { ssum += (xn[0][0] * xn[0][0] + xn[0][1] * xn[0][1]) + (xn[0][2] * xn[0][2] + xn[0][3] * xn[0][3]) + (xn[1][0] * xn[1][0] + xn[1][1] * xn[1][1]) + (xn[1][2] * xn[1][2] + xn[1][3] * xn[1][3]);
                        *(PG8_GAS u32x4*)(XB + (size_t)row * 1024 + col) = pack8(xn[0] * wv[bj][0], xn[1] * wv[bj][1]); } }
                if (NEXT) { { auto r16 = __builtin_amdgcn_permlane16_swap(__float_as_uint(ssum), __float_as_uint(ssum), false, false); ssum = __uint_as_float(r16[0]) + __uint_as_float(r16[1]); }
                    { auto r32 = __builtin_amdgcn_permlane32_swap(__float_as_uint(ssum), __float_as_uint(ssum), false, false); ssum = __uint_as_float(r32[0]) + __uint_as_float(r32[1]); }
                    if (fq == 0) (void)__hip_atomic_fetch_add((PG8_GAS float*)SSo + row, ssum, __ATOMIC_RELAXED, __HIP_MEMORY_SCOPE_AGENT); } }
    }
};
struct EpiMergeCat {
    static constexpr bool PERM = true, AFTER_DRAIN = false, HAS_MID = true, PF = true, SLAB = false; static constexpr int ND = 0;
    const bf16_t* GR; const bf16_t* GS; bf16_t* O;
    __device__ __forceinline__ void mid(f32x4 (&acc)[2][2][4][2], const Unit& u, int wr, int wc, int fr, int fq) const {
        int fr_ = fr; asm volatile("" : "+v"(fr_));
        const unsigned off0 = (unsigned)((u.pm * BM + wr * 64 + fr_) * 1024 + u.pn * BM + wc * 32 + 8 * fq) * 2u;
        const PG8_GAS unsigned char* gr = (const PG8_GAS unsigned char*)GR; const PG8_GAS unsigned char* gs = (const PG8_GAS unsigned char*)GS;
#pragma unroll
        for (int ai = 0; ai < 2; ++ai) {
            u32x4 rv[4][2], sv[4][2];
#pragma unroll
            for (int m = 0; m < 4; ++m)
#pragma unroll
                for (int bj = 0; bj < 2; ++bj) { const unsigned off = off0 + (unsigned)((ai * HALF + m * 16) * 2048 + bj * 256); rv[m][bj] = __builtin_nontemporal_load((const PG8_GAS u32x4*)(gr + off)); sv[m][bj] = *(const PG8_GAS u32x4*)(gs + off); }
#pragma unroll
            for (int m = 0; m < 4; ++m)
#pragma unroll
                for (int bj = 0; bj < 2; ++bj) { f32x4 r0, r1, s0, s1; unpack8(rv[m][bj], r0, r1); unpack8(sv[m][bj], s0, s1);
#pragma unroll
                    for (int e = 0; e < 4; ++e) { acc[ai][bj][m][0][e] *= r0[e] * __builtin_amdgcn_rcpf(fmaxf(s0[e], 1e-30f)); acc[ai][bj][m][1][e] *= r1[e] * __builtin_amdgcn_rcpf(fmaxf(s1[e], 1e-30f)); } }
            asm volatile("" ::: "memory"); }
    }
    __device__ __forceinline__ void operator()(f32x4 (&acc)[2][2][4][2], const Unit& u, int wr, int wc, int fr, int fq) const {
        const int row0 = u.pm * BM + wr * 64 + fr, col0 = u.pn * BM + wc * 32 + 8 * fq;
#pragma unroll
        for (int ai = 0; ai < 2; ++ai)
#pragma unroll
            for (int m = 0; m < 4; ++m) { const size_t off = (size_t)(row0 + ai * HALF + m * 16) * 1024 + col0;
#pragma unroll
                for (int bj = 0; bj < 2; ++bj) { f32x4 s0, s1; unpack8(__builtin_nontemporal_load((const PG8_GAS u32x4*)(GS + off + bj * HALF)), s0, s1);
                    *(PG8_GAS u32x4*)(O + off + bj * HALF) = pack8(s0 * acc[ai][bj][m][0], s1 * acc[ai][bj][m][1]); } }
    }
};
struct EpiProj {
    static constexpr bool PERM = true, AFTER_DRAIN = false, HAS_MID = false, PF = false, SLAB = false; static constexpr int ND = 0;
    bf16_t *RQ, *RK, *RV, *RG, *SQ, *SK, *SV, *GR, *GS; const float *cosr, *sinr, *coss, *sins; const float* SS; const float* T;
    __device__ __forceinline__ void operator()(f32x4 (&acc)[2][2][4][2], const Unit& u, int wr, int wc, int fr, int fq) const {
        if (SS) fold_apply(acc, u, wr, wc, fr, fq, SS, T);
        const int pn = u.pn, row0 = u.pm * BM + wr * 64 + fr, j0 = wc * 32 + 8 * fq;
        if (pn < 4) {
            const bool isq = pn < 2; const int head = 2 * (pn & 1) + (wc >> 1), i0 = j0 & 63;
            bf16_t* O = isq ? RQ : RK;
            const float lg = __log2f(1.0f - __builtin_amdgcn_exp2f(-5.0f - (float)head)) * (isq ? 1.0f : -1.0f);
            const float sc = isq ? 0.08838834764831845f : 1.0f;
#pragma unroll
            for (int ai = 0; ai < 2; ++ai)
#pragma unroll
                for (int m = 0; m < 4; ++m) { const int row = row0 + ai * HALF + m * 16; const float dec = __builtin_amdgcn_exp2f((float)(row & 127) * lg) * sc;
                    f32x4 o1[2], o2[2];
#pragma unroll
                    for (int n = 0; n < 2; ++n) { const f32x4 c = *(const PG8_GAS f32x4*)(cosr + (size_t)row * 64 + i0 + 4 * n), s = *(const PG8_GAS f32x4*)(sinr + (size_t)row * 64 + i0 + 4 * n);
                        const f32x4 x1 = acc[ai][0][m][n], x2 = acc[ai][1][m][n]; o1[n] = (x1 * c - x2 * s) * dec; o2[n] = (x2 * c + x1 * s) * dec; }
                    bf16_t* p = O + (size_t)row * 512 + head * 128 + i0; *(PG8_GAS u32x4*)p = pack8(o1[0], o1[1]); *(PG8_GAS u32x4*)(p + 64) = pack8(o2[0], o2[1]); if (m & 1) asm volatile("" ::: "memory"); }
        } else if (pn < 12) {
            const bool isg = pn >= 8; bf16_t* O = isg ? RG : RV; const int colt = ((pn - 4) & 3) * 256 + j0;
#pragma unroll
            for (int ai = 0; ai < 2; ++ai)
#pragma unroll
                for (int m = 0; m < 4; ++m) { const int row = row0 + ai * HALF + m * 16;
#pragma unroll
                    for (int bj = 0; bj < 2; ++bj) { f32x4 v0 = acc[ai][bj][m][0], v1 = acc[ai][bj][m][1];
                        if (isg) {
#pragma unroll
                            for (int e = 0; e < 4; ++e) { v0[e] = fsilu(v0[e]); v1[e] = fsilu(v1[e]); } }
                        *(PG8_GAS u32x4*)(O + prow((size_t)row) + colt + bj * HALF) = pack8(v0, v1); } }
        } else if (pn < 16 || (pn == 16 && wc < 2)) {
            const bool isq = pn < 16; const int head = isq ? 4 * (pn - 12) + wc : wc, i0 = 8 * fq;
            bf16_t* O = isq ? SQ : SK; const float sc = isq ? 0.125f * 1.4426950408889634f : 1.0f;
#pragma unroll
            for (int ai = 0; ai < 2; ++ai)
#pragma unroll
                for (int m = 0; m < 4; ++m) { const int row = row0 + ai * HALF + m * 16;
                    f32x4 o1[2], o2[2];
#pragma unroll
                    for (int n = 0; n < 2; ++n) { const f32x4 c = *(const PG8_GAS f32x4*)(coss + (size_t)row * 32 + i0 + 4 * n), s = *(const PG8_GAS f32x4*)(sins + (size_t)row * 32 + i0 + 4 * n);
                        const f32x4 x1 = acc[ai][0][m][n], x2 = acc[ai][1][m][n]; o1[n] = (x1 * c - x2 * s) * sc; o2[n] = (x2 * c + x1 * s) * sc; }
                    bf16_t* p = O + (isq ? prow((size_t)row) : (size_t)row * 128) + head * 64 + i0; *(PG8_GAS u32x4*)p = pack8(o1[0], o1[1]); *(PG8_GAS u32x4*)(p + 32) = pack8(o2[0], o2[1]); if (m & 1) asm volatile("" ::: "memory"); }
        } else if (pn == 16) {
            const int jj = (wc - 2) * 32 + 8 * fq;
#pragma unroll
            for (int ai = 0; ai < 2; ++ai)
#pragma unroll
                for (int m = 0; m < 4; ++m) { const int row = row0 + ai * HALF + m * 16;
#pragma unroll
                    for (int bj = 0; bj < 2; ++bj) *(PG8_GAS u32x4*)(SV + (size_t)row * 128 + bj * 64 + jj) = pack8(acc[ai][bj][m][0], acc[ai][bj][m][1]); }
        } else {
            bf16_t* O = pn >= 21 ? GS : GR; const int colt = ((pn - 17) & 3) * 256 + j0;
#pragma unroll
            for (int ai = 0; ai < 2; ++ai)
#pragma unroll
                for (int m = 0; m < 4; ++m) { const int row = row0 + ai * HALF + m * 16;
#pragma unroll
                    for (int bj = 0; bj < 2; ++bj) { f32x4 v0 = acc[ai][bj][m][0], v1 = acc[ai][bj][m][1];
#pragma unroll
#ifndef DBG_RAW_GATES
                        for (int e = 0; e < 4; ++e) { v0[e] = fsigmoid(v0[e]); v1[e] = fsigmoid(v1[e]); }
#else
                        for (int e = 0; e < 4; ++e) { v0[e] = v0[e] * 0.25f; v1[e] = v1[e] * 0.25f; }
#endif
                        *(PG8_GAS u32x4*)(O + (size_t)row * 1024 + colt + bj * HALF) = pack8(v0, v1); } }
        }
    }
};
}
#define GAS __attribute__((address_space(1)))
#define LAS __attribute__((address_space(3)))
typedef unsigned short bf16;
typedef unsigned v4u __attribute__((ext_vector_type(4)));
typedef float f32x4 __attribute__((ext_vector_type(4)));
typedef short bf16x8 __attribute__((ext_vector_type(8)));
typedef GAS unsigned gu32;
typedef GAS unsigned long long gu64;
#define RLX_AGENT __ATOMIC_RELAXED, __HIP_MEMORY_SCOPE_AGENT
#define LDS_WAIT() asm volatile("s_waitcnt lgkmcnt(0)" ::: "memory")
#define VM_WAIT() asm volatile("s_waitcnt vmcnt(0)" ::: "memory")
__device__ __forceinline__ unsigned long long rt() { return __builtin_amdgcn_s_memrealtime(); }
__device__ __forceinline__ unsigned f2bf(float f) { unsigned u = __builtin_bit_cast(unsigned, f); return (u + 0x7fffu + ((u >> 16) & 1u)) >> 16; }
__device__ __forceinline__ unsigned pk2(float lo, float hi) { return f2bf(lo) | (f2bf(hi) << 16); }

#define XB_TMO      128
#define XB_XCNT(j)  (256  + 64 * (j))
#define XB_XSUB(j)  (1280 + 64 * (j))
#define XB_XGEN(j)  (2304 + 64 * (j))
#define XB_TOP      3328
#define XB_TOPGEN   3392
#define XCD_BAR_WORDS 3456
#define XB_SPIN_CAP (1u << 18)

__device__ __forceinline__ unsigned xb_ld(unsigned* p)              { return __hip_atomic_load(p, __ATOMIC_RELAXED, __HIP_MEMORY_SCOPE_AGENT); }
__device__ __forceinline__ unsigned xb_add(unsigned* p, unsigned v) { return __hip_atomic_fetch_add(p, v, __ATOMIC_RELAXED, __HIP_MEMORY_SCOPE_AGENT); }
__device__ __forceinline__ unsigned xb_xcc_id() { return (unsigned)__builtin_amdgcn_s_getreg((3 << 11) | 20) & 0xFu; }
#define XB_SPIN(cond, bar) do { unsigned _sp = 0; while (cond) { __builtin_amdgcn_s_sleep(1); \
    if ((++_sp & 255u) == 0u) { if (xb_ld(&(bar)[XB_TMO])) break; if (_sp > XB_SPIN_CAP) { atomicAdd(&(bar)[XB_TMO], 1u); break; } } } } while (0)

__device__ __forceinline__ int xb_lane_id() { int l_; asm volatile("v_mbcnt_lo_u32_b32 %0, -1, 0\n\tv_mbcnt_hi_u32_b32 %0, -1, %0" : "=v"(l_)); return l_; }
struct XcdBarrier {
    unsigned w0;
    unsigned* bar; unsigned x;
    volatile LAS unsigned* st;
};

__device__ __forceinline__ XcdBarrier xcd_barrier_post(unsigned* bar, volatile LAS unsigned* st) {
    XcdBarrier b; b.w0 = 0u; b.bar = bar; b.x = xb_xcc_id(); b.st = st;
    if (threadIdx.x == 0) (void)xb_add(&bar[XB_XCNT(b.x)], 1u);
    return b;
}
__device__ __forceinline__ void xcd_barrier_complete(unsigned* bar, unsigned x, unsigned& nloc, unsigned& nx) {
    const unsigned G = gridDim.x * gridDim.y * gridDim.z;
    unsigned sum, cnt, mine, sp = 0u;
    for (;;) {
        sum = 0u; cnt = 0u; mine = 0u;
#pragma unroll
        for (unsigned j = 0; j < 16; ++j) { const unsigned c = xb_ld(&bar[XB_XCNT(j)]); sum += c; cnt += (c > 0u) ? 1u : 0u; mine = (j == x) ? c : mine; }
        if (sum == G) break;
        __builtin_amdgcn_s_sleep(1);
        if ((++sp & 255u) == 0u) { if (xb_ld(&bar[XB_TMO])) break; if (sp > XB_SPIN_CAP) { atomicAdd(&bar[XB_TMO], 1u); break; } }
    }
    nloc = mine > 0u ? mine : 1u; nx = cnt > 0u ? cnt : 1u;
}

__device__ __forceinline__ void xcd_barrier(const XcdBarrier& b) {
    asm volatile("s_waitcnt vmcnt(0)" ::: "memory");
    __syncthreads();
    if (b.w0 == 0u && xb_lane_id() == 0) {
        unsigned* bar = b.bar;
        __builtin_amdgcn_s_waitcnt(0);
        unsigned nloc = b.st[0], nx = b.st[1];
        if (nloc == 0u) { xcd_barrier_complete(bar, b.x, nloc, nx); b.st[0] = nloc; b.st[1] = nx; }
        const unsigned old = xb_add(&bar[XB_XSUB(b.x)], 1u);
        const unsigned gen = old / nloc;
        if (old + 1u == (gen + 1u) * nloc) {
            __builtin_amdgcn_fence(__ATOMIC_RELEASE, "agent");
            asm volatile("s_waitcnt vmcnt(0)" ::: "memory");
            const unsigned og = xb_add(&bar[XB_TOP], 1u);
            const unsigned tg = og / nx;
            if (og + 1u == (tg + 1u) * nx) xb_add(&bar[XB_TOPGEN], 1u);
            else XB_SPIN(xb_ld(&bar[XB_TOPGEN]) == tg, bar);
            __builtin_amdgcn_fence(__ATOMIC_ACQUIRE, "agent");
            xb_add(&bar[XB_XGEN(b.x)], 1u);
            asm volatile("s_waitcnt vmcnt(0)" ::: "memory");
        } else {
            XB_SPIN(xb_ld(&bar[XB_XGEN(b.x)]) == gen, bar);
            __builtin_amdgcn_fence(__ATOMIC_ACQUIRE, "agent");
            asm volatile("s_waitcnt vmcnt(0)" ::: "memory");
        }
    }
    __syncthreads();
}

struct GroupBar { unsigned* cnt; unsigned epoch; unsigned same_xcd; unsigned w0; unsigned next_same; };
__device__ __forceinline__ void group_barrier(GroupBar& gb, unsigned* tmo, unsigned* xcnt = nullptr, unsigned xwant = 0u, unsigned* nbr = nullptr, bool pub_next = false) {
    asm volatile("s_waitcnt vmcnt(0)" ::: "memory");
    __syncthreads();
    gb.epoch += 1u;
    if (gb.w0 == 0u && xb_lane_id() == 0) {
        if (!gb.same_xcd || (pub_next && !gb.next_same)) { __builtin_amdgcn_fence(__ATOMIC_RELEASE, "agent"); asm volatile("s_waitcnt vmcnt(0)" ::: "memory"); }
        (void)xb_add(gb.cnt, 1u);
        const unsigned want = 4u * gb.epoch; unsigned sp = 0u;
        while (xb_ld(gb.cnt) < want) { __builtin_amdgcn_s_sleep(1); if ((++sp & 255u) == 0u) { if (xb_ld(tmo)) break; if (sp > XB_SPIN_CAP) { atomicAdd(tmo, 1u); break; } } }
        if (nbr) { sp = 0u; while (xb_ld(nbr) < want) { __builtin_amdgcn_s_sleep(1); if ((++sp & 255u) == 0u) { if (xb_ld(tmo)) break; if (sp > XB_SPIN_CAP) { atomicAdd(tmo, 1u); break; } } } }
        if (xcnt) { sp = 0u; while (xb_ld(xcnt) < xwant) { __builtin_amdgcn_s_sleep(1); if ((++sp & 255u) == 0u) { if (xb_ld(tmo)) break; if (sp > XB_SPIN_CAP) { atomicAdd(tmo, 1u); break; } } } }
        __builtin_amdgcn_fence(__ATOMIC_ACQUIRE, "agent");
        asm volatile("s_waitcnt vmcnt(0)" ::: "memory");
    }
    __syncthreads();
}
constexpr int NWAVES = 8, NTHREADS = 512;
#ifndef MK_ONE_LAUNCH
#define MK_ONE_LAUNCH 1
#endif
#ifndef EN_FFN1
#define EN_FFN1 1
#endif
#ifndef EN_MIX
#define EN_MIX 1
#endif
#ifndef EN_FFN2
#define EN_FFN2 1
#endif
constexpr int BATCH = 2, T = 8192, D = 1024, M = BATCH * T, FF = 2816, NUP = 2 * FF, NIN = 6400, NMOD = 9 * D, DEPTH = 2;
constexpr float NORM_EPS = 1e-6f;
constexpr size_t MiB = 1u << 20;
constexpr size_t WS_CTL = 0, CTL_ZERO_BYTES = 64 * 1024;
constexpr size_t WS_MOD = 1 * MiB;
constexpr size_t WS_SS = 1 * MiB + 256 * 1024;
constexpr size_t WS_T = WS_SS + 6 * 65536;
constexpr int T_LD = 6400; constexpr size_t ZERO_BYTES = 768 * 1024;
static_assert(WS_T + (size_t)12 * T_LD * 4 <= WS_SS + ZERO_BYTES && WS_SS + ZERO_BYTES <= 2 * MiB, "ws map (SS, T)");
constexpr size_t WS_COSR = 2 * MiB, WS_SINR = 6 * MiB;
constexpr size_t WS_COSS = 10 * MiB, WS_SINS = 12 * MiB;
constexpr size_t WS_WUP1 = 14 * MiB, WS_WDN1 = 25 * MiB, WS_WIN = WS_WDN1 + 5767168, WS_WBR = 43 * MiB, WS_WBS = 45 * MiB, WS_WOUT = 47 * MiB, WS_WUP2 = 49 * MiB, WS_WDN2 = 60 * MiB;
constexpr size_t WS_XN = 66 * MiB;
constexpr size_t WS_RQ = 98 * MiB, WS_RK = 114 * MiB, WS_RV = 130 * MiB, WS_RG = WS_RV + 512 * 1024, WS_SQ = WS_RV + 1024 * 1024, WS_SK = 226 * MiB, WS_SV = 230 * MiB, WS_GR = 234 * MiB, WS_GS = 266 * MiB;
static_assert(WS_RV + (size_t)(M / 256) * pg8::PSTR * 2 <= WS_SK && pg8::PSTR * 2 == 3 * 512 * 1024 && (size_t)256 * FF * 2 <= pg8::PSTR * 2, "ws map (panel blocks)");
constexpr size_t WS_H = WS_RV;
constexpr int CW_CNV = 13312;
constexpr size_t WS_TMP = 298 * MiB;
constexpr size_t WS_MG = 298 * MiB;
constexpr size_t WS_KV = 298 * MiB;
constexpr size_t WS_END = 330 * MiB;
static_assert(WS_WIN + (size_t)NIN * D * 2 <= WS_WBR && WS_WDN2 + (size_t)D * FF * 2 <= WS_XN && WS_GS + (size_t)M * D * 2 <= WS_KV, "ws map");
constexpr int CW_BAR = 1024, CW_GRP = 8192, CW_XID = 12800;
constexpr int CW_BAR_ = 1024;
constexpr int LDS_BYTES = 163840, MISC_OFF = 156 * 1024;

struct Frame { LAS unsigned char* lds; int tid, lane, wave, vcu, G, w0; };

__device__ __forceinline__ float wave_sum(float v) {
#pragma unroll
    for (int o = 1; o < 64; o <<= 1) v += __shfl_xor(v, o);
    return v;
}
__device__ __forceinline__ float lg2gamma(int h) { return __log2f(1.0f - __builtin_amdgcn_exp2f(-5.0f - (float)h)); }
__device__ __forceinline__ float bf2f(unsigned short b) { return __uint_as_float((unsigned)b << 16); }

constexpr int CV_SCR = 16896;
template <bool WTH = false> __device__ __forceinline__ void conv_item(const float* W, int ldw, int k0, int nsrc_lane, bf16* WT, int ldk, int drow0, LAS float* scr, int lane, float* tacc = nullptr, const float* sh = nullptr) {
    const GAS float* wp = (const GAS float*)W + (size_t)k0 * ldw + nsrc_lane;
    float v[64];
#pragma unroll
    for (int kk = 0; kk < 64; ++kk) v[kk] = __builtin_nontemporal_load(wp + (size_t)kk * ldw);
#pragma unroll
    for (int kk = 0; kk < 64; ++kk) scr[kk * 65 + lane] = v[kk];
    LDS_WAIT(); asm volatile("" ::: "memory");
    if (tacc) { float t0 = 0.f, t1 = 0.f; const GAS float* s0 = (const GAS float*)sh + k0; const GAS float* s1 = s0 + NMOD;
#pragma unroll 16
        for (int kk = 0; kk < 64; ++kk) { const float w = scr[kk * 65 + lane]; t0 += s0[kk] * w; t1 += s1[kk] * w; }
        (void)__hip_atomic_fetch_add((GAS float*)tacc + drow0 + lane, t0, __ATOMIC_RELAXED, __HIP_MEMORY_SCOPE_AGENT); (void)__hip_atomic_fetch_add((GAS float*)tacc + T_LD + drow0 + lane, t1, __ATOMIC_RELAXED, __HIP_MEMORY_SCOPE_AGENT); }
    const int c = lane & 7;
#pragma unroll
    for (int j = 0; j < 8; ++j) { const int n = (lane >> 3) + 8 * j; const LAS float* s = scr + (8 * c) * 65 + n;
        v4u o; o.x = pk2(s[0 * 65], s[1 * 65]); o.y = pk2(s[2 * 65], s[3 * 65]); o.z = pk2(s[4 * 65], s[5 * 65]); o.w = pk2(s[6 * 65], s[7 * 65]);
        GAS v4u* dp = (GAS v4u*)(WT + (size_t)(drow0 + n) * ldk + k0 + 8 * c);
        if (WTH) asm volatile("global_store_dwordx4 %0, %1, off sc1" :: "v"(dp), "v"(o) : "memory"); else *dp = o; }
    LDS_WAIT(); asm volatile("" ::: "memory");
}
__device__ __forceinline__ int map_up(int g) { const int c = 32 * g, pn = c >> 8, bj = (c >> 7) & 1, j = c & 127; return bj * FF + 128 * pn + j; }
__device__ __forceinline__ int map_in(int g) {
    const int c = 32 * g, pn = c >> 8, bj = (c >> 7) & 1, j = c & 127;
    if (pn < 2)  return 0    + (2 * pn + (j >> 6)) * 128 + bj * 64 + (j & 63);
    if (pn < 4)  return 512  + (2 * (pn - 2) + (j >> 6)) * 128 + bj * 64 + (j & 63);
    if (pn < 8)  return 1024 + (pn - 4) * 256 + bj * 128 + j;
    if (pn < 12) return 2048 + (pn - 8) * 256 + bj * 128 + j;
    if (pn < 16) return 3072 + (4 * (pn - 12) + (j >> 5)) * 64 + bj * 32 + (j & 31);
    if (pn == 16) return j < 64 ? 4096 + (j >> 5) * 64 + bj * 32 + (j & 31) : 4224 + bj * 64 + (j - 64);
    if (pn < 21) return 4352 + (pn - 17) * 256 + bj * 128 + j;
    return 5376 + (pn - 21) * 256 + bj * 128 + j;
}
struct LayerW { const float *up1, *dn1, *win, *wbr, *wbs, *wout, *up2, *dn2; float* T; const float* mod; bool t_up1; };
constexpr int CI_UP = 16 * 88, CI_DN = 44 * 16, CI_IN = 16 * 100, CI_SQ = 16 * 16;
constexpr int CV_A0 = 0, CV_A1 = CI_UP + CI_DN, CV_B0 = CV_A1, CV_B1 = CV_B0 + CI_IN + 3 * CI_SQ, CV_C0 = CV_B1, CV_C1 = CV_C0 + CI_UP + CI_DN;
template <bool WTH = false> __device__ __forceinline__ void conv_items(Frame& F, const LayerW& W, unsigned char* ws, int first, int last, int wid, int nw) {
    LAS float* scr = (LAS float*)(F.lds + F.wave * CV_SCR);
    const int hh = F.lane >> 5, l31 = F.lane & 31;
    for (int it = first + wid; it < last; it += nw) {
        int r = it;
        if (r < CI_UP) { const int kb = r / 88, g = r % 88; conv_item<WTH>(W.up1, NUP, 64 * kb, map_up(2 * g + hh) + l31, (bf16*)(ws + WS_WUP1), D, 64 * g, scr, F.lane, (W.T && W.t_up1) ? W.T : nullptr, W.mod + 0 * D); continue; } r -= CI_UP;
        if (r < CI_DN) { const int kb = r / 16, g = r % 16; conv_item<WTH>(W.dn1, D, 64 * kb, 64 * g + F.lane, (bf16*)(ws + WS_WDN1), FF, 64 * g, scr, F.lane); continue; } r -= CI_DN;
        if (r < CI_IN) { const int kb = r / 100, g = r % 100; conv_item<WTH>(W.win, NIN, 64 * kb, map_in(2 * g + hh) + l31, (bf16*)(ws + WS_WIN), D, 64 * g, scr, F.lane, W.T ? W.T + 2 * T_LD : nullptr, W.mod + 3 * D); continue; } r -= CI_IN;
        if (r < CI_SQ) { const int kb = r / 16, g = r % 16; conv_item<WTH>(W.wbr, D, 64 * kb, 64 * g + F.lane, (bf16*)(ws + WS_WBR), 2 * D, 64 * g, scr, F.lane); continue; } r -= CI_SQ;
        if (r < CI_SQ) { const int kb = r / 16, g = r % 16; conv_item<WTH>(W.wbs, D, 64 * kb, 64 * g + F.lane, (bf16*)(ws + WS_WBR) + D, 2 * D, 64 * g, scr, F.lane); continue; } r -= CI_SQ;
        if (r < CI_SQ) { const int kb = r / 16, g = r % 16; conv_item<WTH>(W.wout, D, 64 * kb, 64 * g + F.lane, (bf16*)(ws + WS_WOUT), D, 64 * g, scr, F.lane); continue; } r -= CI_SQ;
        if (r < CI_UP) { const int kb = r / 88, g = r % 88; conv_item<WTH>(W.up2, NUP, 64 * kb, map_up(2 * g + hh) + l31, (bf16*)(ws + WS_WUP2), D, 64 * g, scr, F.lane, W.T ? W.T + 4 * T_LD : nullptr, W.mod + 6 * D); continue; } r -= CI_UP;
        { const int kb = r / 16, g = r % 16; conv_item<WTH>(W.dn2, D, 64 * kb, 64 * g + F.lane, (bf16*)(ws + WS_WDN2), FF, 64 * g, scr, F.lane); }
    }
}
__device__ __forceinline__ void mod_rope_phase(Frame& F, const float* c, const float* w_ada, const float* b_ada, const int* positions, unsigned char* ws) {
    LAS float* cact = (LAS float*)(F.lds);
    LAS float* red = (LAS float*)(F.lds + 8192);
    float* MOD = (float*)(ws + WS_MOD);
    for (int t = F.tid; t < 2 * D; t += NTHREADS) { const float v = ((const GAS float*)c)[t]; cact[t] = v / (1.0f + __expf(-v)); }
    __syncthreads();
    for (int item = F.vcu; item < 256; item += F.G) {
        const int l = item >> 7, n0 = (item & 127) * 72, kg = F.tid / 18, cl = F.tid % 18;
        f32x4 a0 = {0.f, 0.f, 0.f, 0.f}, a1 = {0.f, 0.f, 0.f, 0.f};
        if (F.tid < 504) {
            const float* wp = w_ada + (size_t)l * D * NMOD + n0 + 4 * cl;
#pragma unroll 4
            for (int k = kg; k < D; k += 28) { const f32x4 w = __builtin_nontemporal_load((const GAS f32x4*)(wp + (size_t)k * NMOD)); a0 += w * cact[k]; a1 += w * cact[D + k]; }
            LAS float* rp = red + (kg * 18 + cl) * 8;
#pragma unroll
            for (int e = 0; e < 4; ++e) { rp[e] = a0[e]; rp[4 + e] = a1[e]; }
        }
        __syncthreads();
        if (F.tid < 144) { const int cl2 = F.tid >> 3, comp = F.tid & 7, b = comp >> 2, e = comp & 3; float s = 0.f;
            for (int g = 0; g < 28; ++g) s += red[(g * 18 + cl2) * 8 + comp];
            ((GAS float*)MOD)[(size_t)(l * 2 + b) * NMOD + n0 + 4 * cl2 + e] = s + ((const GAS float*)b_ada)[(size_t)l * NMOD + n0 + 4 * cl2 + e]; }
        __syncthreads();
    }
    GAS float* cosr = (GAS float*)(ws + WS_COSR); GAS float* sinr = (GAS float*)(ws + WS_SINR); GAS float* coss = (GAS float*)(ws + WS_COSS); GAS float* sins = (GAS float*)(ws + WS_SINS);
    const int gt = F.vcu * NTHREADS + F.tid, NGT = F.G * NTHREADS;
    for (int idx = gt; idx < M * 64; idx += NGT) {
        const int row = idx >> 6, i = idx & 63; const float pos = (float)((const GAS int*)positions)[row];
        const float inv = (float)exp2(-(double)i * (13.287712379549449 / 64.0));
        const double a = (double)(pos * inv), n = rint(a * 0.15915494309189535), r = a - n * 6.283185307179586;
        const float rf = (float)r; cosr[idx] = cosf(rf); sinr[idx] = sinf(rf);
        if (!(i & 1)) { const int o = row * 32 + (i >> 1); coss[o] = cosf(rf); sins[o] = sinf(rf); }
    }
}
constexpr int NORM_NB = 8;
__device__ __forceinline__ void norm_phase(Frame& F, const float* xin, const float* gain, const float* shift, const float* scale, bf16* XN, int row_lo, int row_hi) {
    const GAS f32x4* g4 = (const GAS f32x4*)gain + F.lane;
    const int bo = (row_lo >= T) ? NMOD : 0;
    const GAS f32x4* sh4 = (const GAS f32x4*)(shift + bo) + F.lane; const GAS f32x4* sc4 = (const GAS f32x4*)(scale + bo) + F.lane;
    f32x4 w4[4], s4[4];
#pragma unroll
    for (int j = 0; j < 4; ++j) { w4[j] = g4[64 * j] * (sc4[64 * j] + 1.0f); s4[j] = sh4[64 * j]; }
    for (int m0 = row_lo + F.wave * NORM_NB; m0 < row_hi; m0 += NWAVES * NORM_NB) {
        f32x4 v[NORM_NB][4];
#pragma unroll
        for (int r = 0; r < NORM_NB; ++r) { const GAS f32x4* xr = (const GAS f32x4*)(xin + (size_t)(m0 + r) * D) + F.lane;
#pragma unroll
            for (int j = 0; j < 4; ++j) v[r][j] = xr[64 * j]; }
#pragma unroll
        for (int r = 0; r < NORM_NB; ++r) { float s = 0.f;
#pragma unroll
            for (int j = 0; j < 4; ++j) s += (v[r][j].x * v[r][j].x + v[r][j].y * v[r][j].y) + (v[r][j].z * v[r][j].z + v[r][j].w * v[r][j].w);
            const float rstd = 1.0f / sqrtf(wave_sum(s) * (1.0f / D) + NORM_EPS);
            GAS unsigned long long* o8 = (GAS unsigned long long*)(XN + (size_t)(m0 + r) * D) + F.lane;
#pragma unroll
            for (int j = 0; j < 4; ++j) { const f32x4 o = (v[r][j] * rstd) * w4[j] + s4[j];
                o8[64 * j] = (unsigned long long)pk2(o.x, o.y) | ((unsigned long long)pk2(o.z, o.w) << 32); } }
    }
}
typedef _Float16 f16x8 __attribute__((ext_vector_type(8)));
typedef float f32x8 __attribute__((ext_vector_type(8)));
constexpr int XPITCH = 2048;
__device__ __forceinline__ void final_norm_phase(Frame& F, float* out, const float* gain, int row_lo, int row_hi) {
    const GAS f32x4* g4 = (const GAS f32x4*)gain;
    f32x4 w4[4];
#pragma unroll
    for (int j = 0; j < 4; ++j) w4[j] = g4[(j >> 1) * 128 + 2 * F.lane + (j & 1)];
    for (int m0 = row_lo + F.wave * NORM_NB; m0 < row_hi; m0 += NWAVES * NORM_NB) {
        f16x8 hv[NORM_NB][2];
#pragma unroll
        for (int r = 0; r < NORM_NB; ++r) { const GAS f16x8* xr = (const GAS f16x8*)((const _Float16*)out + (size_t)(m0 + r) * XPITCH) + F.lane; hv[r][0] = __builtin_nontemporal_load(xr); hv[r][1] = __builtin_nontemporal_load(xr + 64); }
#pragma unroll
        for (int r = 0; r < NORM_NB; ++r) { const f32x8 a = __builtin_convertvector(hv[r][0], f32x8), b = __builtin_convertvector(hv[r][1], f32x8); float s = 0.f;
#pragma unroll
            for (int e = 0; e < 8; ++e) s += a[e] * a[e] + b[e] * b[e];
            const float rstd = 1.0f / sqrtf(wave_sum(s) * (1.0f / D) + NORM_EPS);
            GAS f32x4* o = (GAS f32x4*)(out + (size_t)(m0 + r) * D);
            __builtin_nontemporal_store((f32x4){a[0], a[1], a[2], a[3]} * rstd * w4[0], o + 2 * F.lane); __builtin_nontemporal_store((f32x4){a[4], a[5], a[6], a[7]} * rstd * w4[1], o + 2 * F.lane + 1);
            __builtin_nontemporal_store((f32x4){b[0], b[1], b[2], b[3]} * rstd * w4[2], o + 128 + 2 * F.lane); __builtin_nontemporal_store((f32x4){b[4], b[5], b[6], b[7]} * rstd * w4[3], o + 128 + 2 * F.lane + 1); }
    }
}
typedef short s16x4 __attribute__((ext_vector_type(4)));
typedef unsigned v2u __attribute__((ext_vector_type(2)));
#define MFMA16(x, y, c) __builtin_amdgcn_mfma_f32_16x16x32_bf16((x), (y), (c), 0, 0, 0)
__device__ __forceinline__ s16x4 tr_read(LAS const unsigned char* p) { return __builtin_bit_cast(s16x4, __builtin_amdgcn_ds_read_tr16_b64_v4i16((LAS s16x4*)p)); }
__device__ __forceinline__ bf16x8 frag_nat(LAS const unsigned char* base, int RS, int r0, int k0, int lane) { return *(LAS const bf16x8*)(base + (r0 + (lane & 15)) * RS + (k0 + 8 * (lane >> 4)) * 2); }
__device__ __forceinline__ bf16x8 frag_tr(LAS const unsigned char* base, int RS, int klo, int khi, int c0, int lane) {
    const int i = lane & 15, q = i >> 2, p = i & 3;
    const s16x4 lo = tr_read(base + (klo + q) * RS + (c0 + 4 * p) * 2), hi = tr_read(base + (khi + q) * RS + (c0 + 4 * p) * 2);
    return (bf16x8){lo[0], lo[1], lo[2], lo[3], hi[0], hi[1], hi[2], hi[3]};
}
__device__ __forceinline__ void stage_tile(LAS unsigned char* dst, int RS, const bf16* src, size_t gstride, int rows, int cpr_log2, int tid) {
    const int total = rows << cpr_log2;
    for (int c = tid; c < total; c += NTHREADS) { const int r = c >> cpr_log2, cc = c & ((1 << cpr_log2) - 1);
        const v4u v = *(const GAS v4u*)(src + (size_t)r * gstride + cc * 8); *(LAS v4u*)(dst + r * RS + cc * 16) = v; }
}
__device__ __forceinline__ unsigned pkbf(float lo, float hi) { return pg8::cvt_pk_bf16(lo, hi); }

constexpr int RS_QK = 272, RS_V = 528;
template <int ROWS, int CPRL> struct TileRegs { static constexpr int NCH = (ROWS << CPRL) / NTHREADS; v4u v[NCH]; };
template <int ROWS, int CPRL, bool NT = false> __device__ __forceinline__ void tile_load(TileRegs<ROWS, CPRL>& t, const bf16* src, int gstride, int tid) {
    const unsigned off0 = (unsigned)(tid >> CPRL) * (unsigned)(gstride * 2) + (unsigned)(tid & ((1 << CPRL) - 1)) * 16u;
    const GAS unsigned char* s = (const GAS unsigned char*)src;
#pragma unroll
    for (int k = 0; k < TileRegs<ROWS, CPRL>::NCH; ++k) { const GAS v4u* p = (const GAS v4u*)(s + off0 + (unsigned)k * (unsigned)((NTHREADS >> CPRL) * gstride * 2)); t.v[k] = NT ? __builtin_nontemporal_load(p) : *p; }
}
template <int ROWS, int CPRL> __device__ __forceinline__ void tile_store(const TileRegs<ROWS, CPRL>& t, LAS unsigned char* dst, int RS, int tid) {
    const int off0 = (tid >> CPRL) * RS + (tid & ((1 << CPRL) - 1)) * 16;
#pragma unroll
    for (int k = 0; k < TileRegs<ROWS, CPRL>::NCH; ++k) *(LAS v4u*)(dst + off0 + k * ((NTHREADS >> CPRL) * RS)) = t.v[k];
}
__device__ __forceinline__ void kv_phase(Frame& F, const bf16* RK, const bf16* RV, bf16* KV, const int u_first, const int u_step, const int u_end) {
    const int lane = F.lane, w = F.wave, i = lane & 15, g = lane >> 4;
    LAS unsigned char* Ks = F.lds; LAS unsigned char* Vs = F.lds + 128 * RS_QK;
    TileRegs<128, 4> tk; TileRegs<128, 5> tv;
    int u = u_first;
    if (u < u_end) { const int b = u >> 8, n = (u >> 2) & 63, h = u & 3; const size_t row0 = (size_t)b * T + n * 128;
        tile_load(tk, RK + row0 * 512 + h * 128, 512, F.tid); tile_load(tv, RV + pg8::prow(row0) + h * 256, 1024, F.tid); }
    while (u < u_end) {
        const int h = u & 3;
        tile_store(tk, Ks, RS_QK, F.tid); tile_store(tv, Vs, RS_V, F.tid);
        __syncthreads();
        const int un = u + u_step;
        if (un < u_end) { const int b = un >> 8, n = (un >> 2) & 63, hn = un & 3; const size_t row0 = (size_t)b * T + n * 128;
            tile_load(tk, RK + row0 * 512 + hn * 128, 512, F.tid); tile_load(tv, RV + pg8::prow(row0) + hn * 256, 1024, F.tid); }
        f32x4 acc[16];
#pragma unroll
        for (int t = 0; t < 16; ++t) acc[t] = (f32x4){0.f, 0.f, 0.f, 0.f};
#pragma unroll
        for (int s = 0; s < 4; ++s) {
            const bf16x8 y = frag_tr(Ks, RS_QK, 32 * s + 8 * g, 32 * s + 8 * g + 4, 16 * w, lane);
#pragma unroll
            for (int t = 0; t < 16; ++t) { const bf16x8 x = frag_tr(Vs, RS_V, 32 * s + 8 * g, 32 * s + 8 * g + 4, 16 * t, lane); acc[t] = MFMA16(x, y, acc[t]); }
        }
        const float sc = __builtin_amdgcn_exp2f(127.0f * lg2gamma(h));
        bf16* o = KV + (size_t)u * 32768 + (16 * w + i) * 256 + 4 * g;
#pragma unroll
        for (int t = 0; t < 16; ++t) { const f32x4 v = acc[t] * sc; *(GAS v2u*)(o + 16 * t) = (v2u){pkbf(v[0], v[1]), pkbf(v[2], v[3])}; }
        __syncthreads();
        u = un;
    }
}
__device__ __forceinline__ void scan_phase(Frame& F, bf16* KV) {
    const int gt = F.vcu * NTHREADS + F.tid, NGT = F.G * NTHREADS;
    for (int idx = gt; idx < 8 * 16384; idx += NGT) {
        const int bh = idx >> 14, e2 = idx & 16383, b = bh >> 2, h = bh & 3;
        GAS unsigned* p = (GAS unsigned*)(KV + ((size_t)(b * 64) * 4 + h) * 32768) + e2;
        const float dec = __builtin_amdgcn_exp2f(128.0f * lg2gamma(h));
        float s0 = 0.f, s1 = 0.f;
#pragma unroll 1
        for (int n0 = 0; n0 < 64; n0 += 16) { unsigned v[16];
#pragma unroll
            for (int k = 0; k < 16; ++k) v[k] = __builtin_nontemporal_load(p + (size_t)(n0 + k) * 65536);
#pragma unroll
            for (int k = 0; k < 16; ++k) { p[(size_t)(n0 + k) * 65536] = pkbf(s0, s1); s0 = dec * s0 + __uint_as_float(v[k] << 16); s1 = dec * s1 + __uint_as_float(v[k] & 0xffff0000u); } }
    }
}
__device__ __forceinline__ void ret_phase(Frame& F, const bf16* RQ, const bf16* RK, const bf16* RV, bf16* RO, const bf16* RG, const bf16* KV, int u_first, int u_step, int u_end) {
    const int lane = F.lane, w = F.wave, i = lane & 15, g = lane >> 4;
    LAS unsigned char* Qs = F.lds; LAS unsigned char* Ks = F.lds + 128 * RS_QK; LAS unsigned char* Rs = F.lds + 256 * RS_QK;
    TileRegs<128, 4> tq, tk; TileRegs<128, 5> tr;
    int u = u_first;
    if (u < u_end) { const int b = u >> 8, n = (u >> 2) & 63, h = u & 3; const size_t row0 = (size_t)b * T + n * 128;
        tile_load<128, 4, true>(tq, RQ + row0 * 512 + h * 128, 512, F.tid); tile_load<128, 4, true>(tk, RK + row0 * 512 + h * 128, 512, F.tid); tile_load<128, 5, true>(tr, KV + (size_t)u * 32768, 256, F.tid); }
    while (u < u_end) {
        const int b = u >> 8, n = (u >> 2) & 63, h = u & 3; const size_t row0 = (size_t)b * T + n * 128;
        tile_store(tq, Qs, RS_QK, F.tid); tile_store(tk, Ks, RS_QK, F.tid); tile_store(tr, Rs, RS_V, F.tid);
        __syncthreads();
        tile_load<128, 5, true>(tr, RV + pg8::prow(row0) + h * 256, 1024, F.tid);
        f32x4 acc[16];
#pragma unroll
        for (int t = 0; t < 16; ++t) acc[t] = (f32x4){0.f, 0.f, 0.f, 0.f};
        bf16x8 yq[4];
#pragma unroll
        for (int s = 0; s < 4; ++s) yq[s] = frag_nat(Qs, RS_QK, 16 * w, 32 * s, lane);
#pragma unroll
        for (int s = 0; s < 4; ++s)
#pragma unroll
            for (int t = 0; t < 16; ++t) { const bf16x8 x = frag_tr(Rs, RS_V, 32 * s + 8 * g, 32 * s + 8 * g + 4, 16 * t, lane); acc[t] = MFMA16(x, yq[s], acc[t]); }
        const float gam = __builtin_amdgcn_exp2f(lg2gamma(h));
#pragma unroll
        for (int t = 0; t < 16; ++t) acc[t] *= gam;
        __builtin_amdgcn_sched_barrier(0);
        bf16x8 pf[4];
#pragma unroll
        for (int kp = 0; kp < 4; ++kp) {
            f32x4 sa = (f32x4){0.f, 0.f, 0.f, 0.f}, sb = (f32x4){0.f, 0.f, 0.f, 0.f};
            if (2 * kp <= w) {
#pragma unroll
                for (int s = 0; s < 4; ++s) { sa = MFMA16(frag_nat(Ks, RS_QK, 32 * kp, 32 * s, lane), yq[s], sa); sb = MFMA16(frag_nat(Ks, RS_QK, 32 * kp + 16, 32 * s, lane), yq[s], sb); }
            }
            const int ti = 16 * w + i, ja = 32 * kp + 4 * g, jb = ja + 16;
#pragma unroll
            for (int r = 0; r < 4; ++r) { if (ja + r > ti) sa[r] = 0.f; if (jb + r > ti) sb[r] = 0.f; }
            const unsigned p0 = pkbf(sa[0], sa[1]), p1 = pkbf(sa[2], sa[3]), p2 = pkbf(sb[0], sb[1]), p3 = pkbf(sb[2], sb[3]);
            pf[kp] = __builtin_bit_cast(bf16x8, (v4u){p0, p1, p2, p3});
        }
        __syncthreads();
        tile_store(tr, Rs, RS_V, F.tid);
        __syncthreads();
        const int un = u + u_step;
        const size_t ob = pg8::prow(row0 + 16 * w + i) + h * 256 + 4 * g;
        v2u gz[16];
#pragma unroll
        for (int t = 0; t < 16; ++t) gz[t] = __builtin_nontemporal_load((const GAS v2u*)(RG + ob + 16 * t));
#pragma unroll
        for (int kp = 0; kp < 4; ++kp) {
            if (2 * kp <= w) {
#pragma unroll
                for (int t = 0; t < 16; ++t) { const bf16x8 x = frag_tr(Rs, RS_V, 32 * kp + 4 * g, 32 * kp + 16 + 4 * g, 16 * t, lane); acc[t] = MFMA16(x, pf[kp], acc[t]); }
            }
        }
        asm volatile("" ::: "memory"); __builtin_amdgcn_sched_barrier(0);
        if (un < u_end) { const int bn = un >> 8, nn = (un >> 2) & 63, hn = un & 3; const size_t rown = (size_t)bn * T + nn * 128;
            tile_load<128, 4, true>(tq, RQ + rown * 512 + hn * 128, 512, F.tid); tile_load<128, 4, true>(tk, RK + rown * 512 + hn * 128, 512, F.tid); tile_load<128, 5, true>(tr, KV + (size_t)un * 32768, 256, F.tid); }
        float s = 0.f;
#pragma unroll
        for (int t = 0; t < 16; ++t) s += (acc[t][0] + acc[t][1]) + (acc[t][2] + acc[t][3]);
        s += __shfl_xor(s, 16); s += __shfl_xor(s, 32);
        const float mu = s * (1.0f / 256.0f); float q = 0.f;
#pragma unroll
        for (int t = 0; t < 16; ++t) { const f32x4 d = acc[t] - mu; q += (d[0] * d[0] + d[1] * d[1]) + (d[2] * d[2] + d[3] * d[3]); }
        q += __shfl_xor(q, 16); q += __shfl_xor(q, 32);
        const float rstd = 1.0f / sqrtf(q * (1.0f / 256.0f) + NORM_EPS);
#pragma unroll
        for (int t = 0; t < 16; ++t) {
            const float o0 = (acc[t][0] - mu) * rstd * __uint_as_float(gz[t].x << 16), o1 = (acc[t][1] - mu) * rstd * __uint_as_float(gz[t].x & 0xffff0000u);
            const float o2 = (acc[t][2] - mu) * rstd * __uint_as_float(gz[t].y << 16), o3 = (acc[t][3] - mu) * rstd * __uint_as_float(gz[t].y & 0xffff0000u);
            *(GAS v2u*)(RO + ob + 16 * t) = (v2u){pkbf(o0, o1), pkbf(o2, o3)}; }
        __syncthreads();
        u = un;
    }
}
constexpr int RS_S = 144;
__device__ __forceinline__ void swa_unit(Frame& F, int u, const bf16* SQ, bf16* SO, const bf16* SK, const bf16* SV, const float* sinks) {
    const int b = u >> 7, n = (u >> 1) & 63, kvh = u & 1, lane = F.lane, w = F.wave, i = lane & 15, g = lane >> 4;
    LAS unsigned char* Ks = F.lds; LAS unsigned char* Vs = F.lds + 272 * RS_S;
    const int hq = kvh * 8 + w;
    const bf16* qbase = SQ + pg8::prow((size_t)b * T + n * 128 + i) + hq * 64; bf16* obase = SO + pg8::prow((size_t)b * T + n * 128 + i) + hq * 64;
    bf16x8 yq0 = __builtin_nontemporal_load((const GAS bf16x8*)(qbase + 8 * g)), yq1 = __builtin_nontemporal_load((const GAS bf16x8*)(qbase + 32 + 8 * g));
    { v4u kv[5], vv[5];
#pragma unroll
        for (int k = 0; k < 5; ++k) { const int c = F.tid + k * NTHREADS, r = c >> 3, cc = c & 7; kv[k] = (v4u){0u, 0u, 0u, 0u}; vv[k] = kv[k];
            if (r < 256 && (n > 0 || r >= 128)) { const size_t tok = (size_t)b * T + (n - 1) * 128 + r; kv[k] = *(const GAS v4u*)(SK + tok * 128 + kvh * 64 + cc * 8); vv[k] = *(const GAS v4u*)(SV + tok * 128 + kvh * 64 + cc * 8); } }
#pragma unroll
        for (int k = 0; k < 5; ++k) { const int c = F.tid + k * NTHREADS, r = c >> 3, cc = c & 7; if (c < 272 * 8) { *(LAS v4u*)(Ks + r * RS_S + cc * 16) = kv[k]; *(LAS v4u*)(Vs + r * RS_S + cc * 16) = vv[k]; } } }
    __syncthreads();
    const float sink = ((const GAS float*)sinks)[hq] * 1.4426950408889634f;
    float am0[4], am8[4];
#pragma unroll
    for (int r = 0; r < 4; ++r) { am0[r] = (4 * g + r <= i) ? -INFINITY : 0.f; am8[r] = (4 * g + r > i) ? -INFINITY : 0.f; }
#pragma unroll 1
    for (int qb = 0; qb < 8; ++qb) {
        const bf16* qn = qbase + (size_t)(qb < 7 ? 16 * (qb + 1) : 16 * qb) * 1024;
        const bf16x8 nq0 = __builtin_nontemporal_load((const GAS bf16x8*)(qn + 8 * g)), nq1 = __builtin_nontemporal_load((const GAS bf16x8*)(qn + 32 + 8 * g));
        bf16* op = obase + (size_t)(16 * qb) * 1024;
        f32x4 st[10]; float mx = sink;
#pragma unroll
        for (int jt = 0; jt < 9; ++jt) { const int J = qb + jt;
            f32x4 a = (f32x4){0.f, 0.f, 0.f, 0.f};
            a = MFMA16(frag_nat(Ks, RS_S, 16 * J, 0, lane), yq0, a); a = MFMA16(frag_nat(Ks, RS_S, 16 * J, 32, lane), yq1, a);
            if (jt == 0) { a[0] += am0[0]; a[1] += am0[1]; a[2] += am0[2]; a[3] += am0[3]; }
            if (jt == 8) { a[0] += am8[0]; a[1] += am8[1]; a[2] += am8[2]; a[3] += am8[3]; }
            if (n == 0 && J < 8) a = (f32x4){-INFINITY, -INFINITY, -INFINITY, -INFINITY};
            mx = fmaxf(fmaxf(mx, fmaxf(a[0], a[1])), fmaxf(a[2], a[3]));
            st[jt] = a; }
        mx = fmaxf(mx, __shfl_xor(mx, 16)); mx = fmaxf(mx, __shfl_xor(mx, 32));
        float sum = 0.f;
#pragma unroll
        for (int jt = 0; jt < 9; ++jt)
#pragma unroll
            for (int r = 0; r < 4; ++r) { const float p = __builtin_amdgcn_exp2f(st[jt][r] - mx); st[jt][r] = p; sum += p; }
        st[9] = (f32x4){0.f, 0.f, 0.f, 0.f};
        sum += __shfl_xor(sum, 16); sum += __shfl_xor(sum, 32);
        const float inv = 1.0f / (sum + __builtin_amdgcn_exp2f(sink - mx));
        f32x4 o[4];
#pragma unroll
        for (int dt = 0; dt < 4; ++dt) o[dt] = (f32x4){0.f, 0.f, 0.f, 0.f};
#pragma unroll
        for (int kp = 0; kp < 5; ++kp) { const f32x4 pa = st[2 * kp], pb = st[2 * kp + 1];
            const bf16x8 pfr = __builtin_bit_cast(bf16x8, (v4u){pkbf(pa[0], pa[1]), pkbf(pa[2], pa[3]), pkbf(pb[0], pb[1]), pkbf(pb[2], pb[3])});
            const int ka = 16 * (qb + 2 * kp) + 4 * g;
#pragma unroll
            for (int dt = 0; dt < 4; ++dt) { const bf16x8 x = frag_tr(Vs, RS_S, ka, ka + 16, 16 * dt, lane); o[dt] = MFMA16(x, pfr, o[dt]); } }
#pragma unroll
        for (int dt = 0; dt < 4; ++dt) { const f32x4 ov = o[dt] * inv; *(GAS v2u*)(op + 16 * dt + 4 * g) = (v2u){pkbf(ov[0], ov[1]), pkbf(ov[2], ov[3])}; }
        yq0 = nq0; yq1 = nq1;
    }
    __syncthreads();
}
#ifndef DBG_P11_A
#define DBG_P11_A WS_XN
#endif
#ifndef PH_MASK
#define PH_MASK 0xFFFF
#endif
#define PH_ON(s) (((PH_MASK) >> (s)) & 1)
struct Args { const void* in[18]; float* out; unsigned char* ws; int ph_lo, ph_hi; };
constexpr int PH_PER_LAYER = 15, N_PHASES = DEPTH * PH_PER_LAYER + 1;
#ifndef PROBE_GB
#define PROBE_GB 0
#endif
#ifndef GEMM_SP2
#define GEMM_SP2 true
#endif
#ifndef DBG_REP
#define DBG_REP 0
#endif
#ifndef USE_GROUP_BAR
#define USE_GROUP_BAR 1
#endif
#if DBG_REP
#define COEF_(x) (dry ? 0.0f : (x))
#define XBSEL_(p) (dry ? (bf16*)nullptr : (p))
#else
#define COEF_(x) (x)
#define XBSEL_(p) (p)
#endif
#define PH_BEGIN(k) if (PH_ON((k) % 15 + ((k) == 30 ? 15 : 0)) && lo <= (k) && (k) < hi) { \
      for (int rep_ = ((DBG_REP >> ((k) % 15)) & 1) && (k) != 30 ? 1 : 0; rep_ >= 0; --rep_) { const bool dry = rep_ > 0; (void)dry; \
        { const int t_ = F.w0 * 64 + xb_lane_id(); F.tid = t_; F.lane = t_ & 63; F.wave = F.w0; } \
        unsigned char* ws = ws_; asm volatile("" : "+s"(ws));
#define PH_END(k) if ((k) + 1 < hi || rep_ > 0) xcd_barrier(bar); } }
#define PH_END_GROUP(k) if (rep_ > 0) xcd_barrier(bar); else if ((k) + 1 < hi) { if (USE_GROUP_BAR) group_barrier(gb, tmo_); else xcd_barrier(bar); } } }
#define PH_END_SEL(k, grid) if (rep_ > 0) xcd_barrier(bar); else if ((k) + 1 < hi) { if ((grid) || !USE_GROUP_BAR) xcd_barrier(bar); else group_barrier(gb, tmo_); } } }
#define PH_END_NONE(k) if (rep_ > 0) xcd_barrier(bar); } }
#define COMMA_ ,
#define GEMM_PHASE_PF(EPI, Aptr, Wptr, Ncols, Kdim, PFptr, PFpitch, ...) do { pg8::Gemm g{(const bf16*)(Aptr), (const bf16*)(Wptr), M, (Ncols), (Kdim)}; g.pf = (PFptr); g.pf_pitch = (PFpitch); pg8::StaticOrder S; S.init(M, (Ncols), F.G, (int)blockIdx.x); \
        EPI E{__VA_ARGS__}; pg8::gemm_phase<EPI, pg8::StaticOrder, true, GEMM_SP2>(F.lds, g, S, E, F.w0); } while (0)
#define GEMM_PHASE_PFS(EPI, Aptr, Wptr, Ncols, Kdim, PFptr, PFpitch, ...) do { pg8::Gemm g{(const bf16*)(Aptr), (const bf16*)(Wptr), M, (Ncols), (Kdim)}; g.a_tile = pg8::PSTR * 2; g.pf = (PFptr); g.pf_pitch = (PFpitch); pg8::StaticOrder S; S.init(M, (Ncols), F.G, (int)blockIdx.x); \
        EPI E{__VA_ARGS__}; pg8::gemm_phase<EPI, pg8::StaticOrder, true, GEMM_SP2>(F.lds, g, S, E, F.w0); } while (0)
#define GEMM_PHASE(EPI, Aptr, Wptr, Ncols, Kdim, ...) do { pg8::Gemm g{(const bf16*)(Aptr), (const bf16*)(Wptr), M, (Ncols), (Kdim)}; pg8::StaticOrder S; S.init(M, (Ncols), F.G, (int)blockIdx.x); \
        EPI E{__VA_ARGS__}; pg8::gemm_phase<EPI, pg8::StaticOrder, true, GEMM_SP2>(F.lds, g, S, E, F.w0); } while (0)
template <int L> __device__ __forceinline__ void layer_phases(Frame& F, const Args& args, unsigned char* ws_, const XcdBarrier& bar, GroupBar& gb, unsigned* tmo_, const int pm_own, const int mem_own, const int lo, const int hi) {
    const int nrow_lo = pm_own * 256 + mem_own * 64, nrow_hi = nrow_lo + 64;
    const int ru_first = (pm_own * 2) * 4 + mem_own;
    constexpr int P0 = L * PH_PER_LAYER;
    const float* x_in = (const float*)args.in[0]; float* xres = args.out;
#define X0 (L > 0 ? (const void*)xres : (const void*)x_in)
#define MODL(LL, i) ((const float*)(ws + WS_MOD) + (size_t)(LL) * 2 * NMOD + (i) * D)
#define MODP(i) MODL(L, i)
#define SSP(LL, j) ((float*)(ws + WS_SS) + (size_t)((LL) * 3 + (j)) * M)
#define TPP(LL, j) ((float*)(ws + WS_T) + (size_t)((LL) * 3 + (j)) * 2 * T_LD)
#define LAYERW(W, LL, WITH_T) LayerW W; W.up1 = (const float*)args.in[9] + (size_t)(LL) * D * NUP; W.dn1 = (const float*)args.in[10] + (size_t)(LL) * FF * D; W.up2 = (const float*)args.in[11] + (size_t)(LL) * D * NUP; \
        W.dn2 = (const float*)args.in[12] + (size_t)(LL) * FF * D; W.win = (const float*)args.in[13] + (size_t)(LL) * D * NIN; W.wbr = (const float*)args.in[15] + (size_t)(LL) * D * D; \
        W.wbs = (const float*)args.in[16] + (size_t)(LL) * D * D; W.wout = (const float*)args.in[17] + (size_t)(LL) * D * D; W.T = (WITH_T) ? TPP(LL, 0) : nullptr; W.mod = MODL(LL, 0); W.t_up1 = (LL) == 1;
#define TAIL_CONV(LL, first, last, nunits) TAIL_CONV_(false, LL, first, last, nunits)
#define TAIL_CONV_(WTH, LL, first, last, nunits) do { const int busy_ = (nunits) % F.G; if (busy_ != 0 && (int)blockIdx.x >= busy_) { LAYERW(Wt_, LL, true) \
        { const int t_ = F.w0 * 64 + xb_lane_id(); F.tid = t_; F.lane = t_ & 63; F.wave = F.w0; } \
        conv_items<WTH>(F, Wt_, ws, (first), (last), ((int)blockIdx.x - busy_) * NWAVES + F.wave, (F.G - busy_) * NWAVES); } } while (0)
#define CONV_DONE(LL, nunits) do { const int busy_ = (nunits) % F.G; if (!(PROBE_GB & 4) && busy_ != 0 && (int)blockIdx.x >= busy_) { asm volatile("s_waitcnt vmcnt(0)" ::: "memory"); __syncthreads(); \
        if (F.w0 == 0 && xb_lane_id() == 0) (void)xb_add((unsigned*)(ws_ + WS_CTL) + CW_CNV + 64 * (LL), 1u); } } while (0)
#define PHASE_PASSED(idx) do { asm volatile("s_waitcnt vmcnt(0)" ::: "memory"); __syncthreads(); if (F.w0 == 0 && xb_lane_id() == 0) (void)xb_add((unsigned*)(ws_ + WS_CTL) + CW_CNV + 64 * (idx), 1u); } while (0)
#define PASSED_WAIT(idx, nunits) do { const int busy_ = (nunits) % F.G; if (hi - lo > 1 && busy_ != 0 && (int)blockIdx.x >= busy_) { if (F.w0 == 0 && xb_lane_id() == 0) { unsigned sp_ = 0u; \
        while (xb_ld((unsigned*)(ws_ + WS_CTL) + CW_CNV + 64 * (idx)) < (unsigned)F.G) { __builtin_amdgcn_s_sleep(1); if ((++sp_ & 255u) == 0u) { if (xb_ld(tmo_)) break; if (sp_ > XB_SPIN_CAP) { atomicAdd(tmo_, 1u); break; } } } } \
        __syncthreads(); } } while (0)
#define PH_END_SEL_CW(k, cw, LL, nunits) if (rep_ > 0) xcd_barrier(bar); else if ((k) + 1 < hi) { if (USE_GROUP_BAR) { const int busy_ = (nunits) % F.G; \
        group_barrier(gb, tmo_, ((cw) && busy_ != 0) ? (unsigned*)(ws_ + WS_CTL) + CW_CNV + 64 * (LL) : (unsigned*)nullptr, (unsigned)(F.G - busy_)); } else xcd_barrier(bar); } } }
#define PH_END_GROUP_NBR(k) if (rep_ > 0) xcd_barrier(bar); else if ((k) + 1 < hi) { if (USE_GROUP_BAR) group_barrier(gb, tmo_, nullptr, 0u, (pm_own & 31) != 0 ? (unsigned*)(ws_ + WS_CTL) + CW_GRP + 64 * (pm_own - 1) : (unsigned*)nullptr, true); else xcd_barrier(bar); } } }
#define PH_END_GROUP_CW(k, LL, nunits) if (rep_ > 0) xcd_barrier(bar); else if ((k) + 1 < hi) { if (USE_GROUP_BAR) { const int busy_ = (nunits) % F.G; \
        group_barrier(gb, tmo_, (!(PROBE_GB & 4) && busy_ != 0) ? (unsigned*)(ws_ + WS_CTL) + CW_CNV + 64 * (LL) : (unsigned*)nullptr, (unsigned)(F.G - busy_)); } else xcd_barrier(bar); } } }
    if (L == 0) {
    PH_BEGIN(P0 + 0)
        LAYERW(W, 0, false)
        { GAS f32x4* z = (GAS f32x4*)(ws + WS_SS); for (int i = F.vcu * NTHREADS + F.tid; i < (int)(ZERO_BYTES / 16); i += F.G * NTHREADS) z[i] = (f32x4){0.f, 0.f, 0.f, 0.f}; }
        mod_rope_phase(F, (const float*)args.in[1], (const float*)args.in[7], (const float*)args.in[8], (const int*)args.in[2], ws);
        conv_items(F, W, ws, CV_A0, CV_A1, F.vcu * NWAVES + F.wave, F.G * NWAVES);
    PH_END(P0 + 0)
    if (lo <= 0 && 1 < hi) {
        unsigned id0 = 0u, same = 1u;
        for (int j = 0; j < 4; ++j) { const unsigned v = xb_ld((unsigned*)(ws_ + WS_CTL) + CW_XID + ((pm_own >> 3) + 8 * (pm_own & 7) + 64 * j)); if (j == 0) id0 = v; same &= (v == id0 && v != 0u) ? 1u : 0u; }
        gb.same_xcd = same;
        unsigned nsame = same; if ((pm_own & 31) != 31) { const int q = pm_own + 1; for (int j = 0; j < 4; ++j) { const unsigned v = xb_ld((unsigned*)(ws_ + WS_CTL) + CW_XID + ((q >> 3) + 8 * (q & 7) + 64 * j)); nsame &= (v == id0 && v != 0u) ? 1u : 0u; } }
        gb.next_same = nsame;
    }
    PH_BEGIN(P0 + 1) norm_phase(F, x_in, (const float*)args.in[3], MODP(0), MODP(1), (bf16*)(ws + WS_XN), nrow_lo, nrow_hi); PH_END_GROUP(P0 + 1)
    }
    PH_BEGIN(P0 + 2) { GEMM_PHASE(pg8::EpiSwiGLU, ws + WS_XN, ws + WS_WUP1, NUP, D, (bf16*)(ws + WS_H), FF, L == 0 ? (const float*)nullptr : (const float*)SSP(0, 2), (const float*)TPP(1, 0)); if (!dry) { if (L == 1) PASSED_WAIT(3, (M / 256) * (NUP / 256)); TAIL_CONV_(true, L, CV_B0, CV_B1, (M / 256) * (NUP / 256)); CONV_DONE(L, (M / 256) * (NUP / 256)); } } PH_END_GROUP(P0 + 2)
    PH_BEGIN(P0 + 3) GEMM_PHASE_PFS(pg8::EpiRes<!DBG_REP COMMA_ (L == 0)>, ws + WS_H, ws + WS_WDN1, D, FF, (const void*)xres, 4096, (const void*)X0, (_Float16*)xres, MODP(2), NMOD, COEF_(0.5f), XBSEL_((bf16*)(ws + WS_XN)), (const float*)args.in[4] + L * D, MODP(4), SSP(L, 0)); PH_END_GROUP_CW(P0 + 3, L, (M / 256) * (NUP / 256))
    PH_BEGIN(P0 + 5) { GEMM_PHASE(pg8::EpiProj, ws + WS_XN, ws + WS_WIN, NIN, D, (bf16*)(ws + WS_RQ), (bf16*)(ws + WS_RK), (bf16*)(ws + WS_RV), (bf16*)(ws + WS_RG), (bf16*)(ws + WS_SQ), (bf16*)(ws + WS_SK), (bf16*)(ws + WS_SV),
            (bf16*)(ws + WS_GR), (bf16*)(ws + WS_GS), (const float*)(ws + WS_COSR), (const float*)(ws + WS_SINR), (const float*)(ws + WS_COSS), (const float*)(ws + WS_SINS), (const float*)SSP(L, 0), (const float*)TPP(L, 1)); if (!dry) { if (L == 1) PASSED_WAIT(4, (M / 256) * (NIN / 256)); TAIL_CONV(L, CV_C0, CV_C1, (M / 256) * (NIN / 256)); } } PH_END_GROUP_NBR(P0 + 5)
    PH_BEGIN(P0 + 6) {
        kv_phase(F, (const bf16*)(ws + WS_RK), (const bf16*)(ws + WS_RV), (bf16*)(ws + WS_KV), ru_first, 4, ru_first + 8);
        { const int u = 4 * pm_own + mem_own; swa_unit(F, u, (bf16*)(ws + WS_SQ), dry ? (bf16*)(ws + WS_H) : (bf16*)(ws + WS_SQ), (const bf16*)(ws + WS_SK), (const bf16*)(ws + WS_SV), (const float*)args.in[14] + L * 16); } }
    PH_END(P0 + 6)
    PH_BEGIN(P0 + 7) if (!dry) scan_phase(F, (bf16*)(ws + WS_KV)); PH_END(P0 + 7)
    PH_BEGIN(P0 + 8) ret_phase(F, (const bf16*)(ws + WS_RQ), (const bf16*)(ws + WS_RK), (const bf16*)(ws + WS_RV), (bf16*)(ws + WS_RV), (const bf16*)(ws + WS_RG), (const bf16*)(ws + WS_KV), ru_first, 4, ru_first + 8); PH_END_GROUP(P0 + 8)
    PH_BEGIN(P0 + 9) { pg8::Gemm g{(const bf16*)(ws + WS_RV), (const bf16*)(ws + WS_WBR), M, D, 2 * D, D, (const bf16*)(ws + WS_SQ)}; g.a_tile = pg8::PSTR * 2; g.pf = (const void*)(ws + WS_GS); g.pf_pitch = 2048; pg8::StaticOrder S; S.init(M, D, F.G, (int)blockIdx.x);
        pg8::EpiMergeCat E{(const bf16*)(ws + WS_GR), (const bf16*)(ws + WS_GS), (bf16*)(ws + WS_MG)}; pg8::gemm_phase<pg8::EpiMergeCat, pg8::StaticOrder, true, true>(F.lds, g, S, E, F.w0); } PH_END_GROUP(P0 + 9)
    PH_BEGIN(P0 + 11) GEMM_PHASE_PF(pg8::EpiRes<!DBG_REP COMMA_ false>, ws + WS_MG, ws + WS_WOUT, D, D, (const void*)xres, 4096, (const void*)xres, (_Float16*)xres, MODP(5), NMOD, COEF_(1.0f), XBSEL_((bf16*)(ws + WS_XN)), (const float*)args.in[5] + L * D, MODP(7), SSP(L, 1)); if (L == 0 && hi - lo > 1) PHASE_PASSED(3); PH_END_GROUP(P0 + 11)
    PH_BEGIN(P0 + 13) { GEMM_PHASE(pg8::EpiSwiGLU, ws + WS_XN, ws + WS_WUP2, NUP, D, (bf16*)(ws + WS_H), FF, (const float*)SSP(L, 1), (const float*)TPP(L, 2)); if (L == 0 && !dry) { TAIL_CONV_(true, 1, CV_A0, CV_A1, (M / 256) * (NUP / 256)); CONV_DONE(2, (M / 256) * (NUP / 256)); } } PH_END_GROUP(P0 + 13)
    PH_BEGIN(P0 + 14) GEMM_PHASE_PFS(pg8::EpiRes<(L == 0) && !DBG_REP COMMA_ false>, ws + WS_H, ws + WS_WDN2, D, FF, (const void*)xres, 4096, (const void*)xres, (_Float16*)xres, MODP(8), NMOD, COEF_(0.5f), (L == 0) ? XBSEL_((bf16*)(ws + WS_XN)) : (bf16*)nullptr, (const float*)args.in[3] + 1 * D, MODL(1, 1), SSP(0, 2)); if (L == 0 && hi - lo > 1) PHASE_PASSED(4); PH_END_SEL_CW(P0 + 14, L == 0, 2, (M / 256) * (NUP / 256))
#undef X0
#undef MODP
}
__global__ void __launch_bounds__(NTHREADS, 2) fwd_kernel(Args args) {
    extern __shared__ __attribute__((aligned(16))) unsigned char lds_raw[];
    Frame F;
    F.lds = (LAS unsigned char*)lds_raw;
    F.tid = threadIdx.x; F.lane = F.tid & 63; F.wave = __builtin_amdgcn_readfirstlane(F.tid >> 6);
    { int w0_ = F.wave; asm volatile("" : "+s"(w0_)); F.w0 = w0_; }
    F.G = gridDim.x; { const int bx = blockIdx.x; F.vcu = (F.G % 8 == 0) ? (bx % 8) * (F.G / 8) + bx / 8 : bx; }
    unsigned char* ws_ = args.ws;
    volatile LAS unsigned* MISC = (volatile LAS unsigned*)(F.lds + MISC_OFF);
    if (F.tid < 32) MISC[F.tid] = 0u;
    __syncthreads();
    const int lo = args.ph_lo, hi = args.ph_hi;
    XcdBarrier bar; bar.bar = (unsigned*)(ws_ + WS_CTL) + CW_BAR; bar.x = 0; bar.st = MISC + 8;
    if (hi - lo > 1) bar = xcd_barrier_post((unsigned*)(ws_ + WS_CTL) + CW_BAR, MISC + 8);
    bar.w0 = (unsigned)F.w0;

    const int pm_own = 8 * ((int)blockIdx.x & 7) + (((int)blockIdx.x >> 3) & 7), mem_own = (int)blockIdx.x >> 6;
    GroupBar gb; gb.cnt = (unsigned*)(ws_ + WS_CTL) + CW_GRP + 64 * pm_own; gb.epoch = 0u; gb.same_xcd = 0u; gb.next_same = 0u; gb.w0 = (unsigned)F.w0;
    unsigned* tmo_ = (unsigned*)(ws_ + WS_CTL) + CW_BAR + XB_TMO;
    if (threadIdx.x == 0) __hip_atomic_store((unsigned*)(ws_ + WS_CTL) + CW_XID + blockIdx.x, xb_xcc_id() + 1u, __ATOMIC_RELAXED, __HIP_MEMORY_SCOPE_AGENT);
    layer_phases<0>(F, args, ws_, bar, gb, tmo_, pm_own, mem_own, lo, hi);
    layer_phases<1>(F, args, ws_, bar, gb, tmo_, pm_own, mem_own, lo, hi);
    const int nrow_lo = pm_own * 256 + mem_own * 64, nrow_hi = nrow_lo + 64;
    PH_BEGIN(30)
        if (EN_FFN1 || EN_MIX || EN_FFN2) final_norm_phase(F, args.out, (const float*)args.in[6], nrow_lo, nrow_hi);
        else { const float* x_in = (const float*)args.in[0]; const int gw = F.vcu * NWAVES + F.wave, NGW = F.G * NWAVES;
            for (int m = gw; m < M; m += NGW) { const GAS f32x4* xr = (const GAS f32x4*)(x_in + (size_t)m * D) + F.lane; GAS f32x4* orow = (GAS f32x4*)(args.out + (size_t)m * D) + F.lane;
                f32x4 v[4]; float ss = 0.f;
                for (int j = 0; j < 4; ++j) { v[j] = xr[64 * j]; ss += (v[j].x * v[j].x + v[j].y * v[j].y) + (v[j].z * v[j].z + v[j].w * v[j].w); }
                const float rstd = 1.0f / sqrtf(wave_sum(ss) * (1.0f / D) + NORM_EPS);
                for (int j = 0; j < 4; ++j) orow[64 * j] = (v[j] * rstd) * ((const GAS f32x4*)args.in[6])[F.lane + 64 * j]; } }
    PH_END(30)
}

extern "C" void kernel_launch(void* const* d_in, const int* in_sizes, int n_in, void* d_out, int out_size, void* d_ws, size_t ws_size, hipStream_t stream) {
    static int grid = 0;
    if (grid == 0) {
        if (n_in != 18 || in_sizes[0] != M * D || out_size != M * D || ws_size < WS_END) { fprintf(stderr, "kernel_launch: unexpected problem (n_in %d, in0 %d, out %d, ws %zu < %zu); nothing launched\n", n_in, n_in > 0 ? in_sizes[0] : -1, out_size, ws_size, (size_t)WS_END); grid = -1; return; }
        int dev = 0, cus = 0, per_cu = 0;
        if (hipGetDevice(&dev) != hipSuccess || hipDeviceGetAttribute(&cus, hipDeviceAttributeMultiprocessorCount, dev) != hipSuccess) { grid = -1; return; }
        if (hipFuncSetAttribute((const void*)fwd_kernel, hipFuncAttributeMaxDynamicSharedMemorySize, LDS_BYTES) != hipSuccess) { fprintf(stderr, "kernel_launch: hipFuncSetAttribute failed\n"); grid = -1; return; }
        if (hipOccupancyMaxActiveBlocksPerMultiprocessor(&per_cu, (const void*)fwd_kernel, NTHREADS, LDS_BYTES) != hipSuccess || per_cu < 1) fprintf(stderr, "kernel_launch: occupancy query says %d\n", per_cu);
        (void)hipGetLastError();
        grid = cus;
        if (grid != 256) { fprintf(stderr, "kernel_launch: this kernel's panel ownership needs exactly 256 workgroups (CUs), device has %d; nothing launched\n", cus); grid = -1; return; }
    }
    if (grid < 0) return;
#ifdef DBG_MEMSET_ALL
    (void)hipMemsetAsync((char*)d_ws, 0x11, WS_END, stream); (void)hipMemsetAsync(d_out, 0x11, (size_t)M * D * 4, stream);
#endif
    if (hipMemsetAsync((char*)d_ws + WS_CTL, 0, CTL_ZERO_BYTES, stream) != hipSuccess) { fprintf(stderr, "kernel_launch: memset failed\n"); return; }
    Args a{};
    for (int i = 0; i < 18; ++i) a.in[i] = d_in[i];
    a.out = (float*)d_out; a.ws = (unsigned char*)d_ws;
#if MK_ONE_LAUNCH
    a.ph_lo = 0; a.ph_hi = N_PHASES;
    hipLaunchKernelGGL(fwd_kernel, dim3(grid), dim3(NTHREADS), LDS_BYTES, stream, a);
#else
    for (int ph = 0; ph < N_PHASES; ++ph) { a.ph_lo = ph; a.ph_hi = ph + 1; hipLaunchKernelGGL(fwd_kernel, dim3(grid), dim3(NTHREADS), LDS_BYTES, stream, a); }
#endif
}
```
